# Optimizing an MI355X kernel written in HIP

```python
import jax
import jax.numpy as jnp
from jax import lax
import numpy as np

D_MODEL = 1024
BATCH = 8
SEQ = 2048
DEPTH = 4

N_MIXERS = 2
N_GLA_LAYERS = (DEPTH + 1) // 2
N_SGU_LAYERS = DEPTH // 2

GLA_HEADS = 4
GLA_DK = D_MODEL // 2
GLA_DV = D_MODEL
GLA_HK = GLA_DK // GLA_HEADS
GLA_HV = GLA_DV // GLA_HEADS
GLA_GATE_RANK = 16
GLA_TAU = 16.0
GLA_CHUNK = 64
GLA_IN = 2 * GLA_DK + 2 * GLA_DV + GLA_GATE_RANK

SGU_WIDTH = 2 * D_MODEL
SGU_GROUPS = 8
SGU_GC = SGU_WIDTH // SGU_GROUPS
SGU_CHUNK = 128

MOE_GROUPS = 4
MOE_EXPERTS_PER_GROUP = 4
MOE_N_EXPERTS = MOE_GROUPS * MOE_EXPERTS_PER_GROUP
MOE_TOP_K = 2
MOE_FF = D_MODEL // 2

PLE_DIM = 256
NORM_EPS = 1e-6

kernel_name = 'hybrid_gla_sgu_hmoe_ple'


def rms_norm(x, g):
    xf = x.astype(jnp.float32)
    y = xf * lax.rsqrt(jnp.mean(xf * xf, axis=-1, keepdims=True) + NORM_EPS)
    return (y * g.astype(jnp.float32)).astype(x.dtype)


def layer_norm(x, g, b):
    xf = x.astype(jnp.float32)
    xc = xf - jnp.mean(xf, axis=-1, keepdims=True)
    y = xc * lax.rsqrt(jnp.mean(xc * xc, axis=-1, keepdims=True) + NORM_EPS)
    return (y * g.astype(jnp.float32) + b.astype(jnp.float32)).astype(x.dtype)


def gla_mixer(h, w_in, w_gate_up, b_gate, g_head, w_out):
    B, S, _ = h.shape
    nc = S // GLA_CHUNK
    z = h @ w_in
    q, k, v, r, a = jnp.split(
        z, [GLA_DK, 2 * GLA_DK, 2 * GLA_DK + GLA_DV, 2 * GLA_DK + 2 * GLA_DV], axis=-1)
    log_alpha = jax.nn.log_sigmoid((a @ w_gate_up + b_gate).astype(jnp.float32)) / GLA_TAU

    def heads(t, dh):
        return t.astype(jnp.float32).reshape(B, nc, GLA_CHUNK, GLA_HEADS, dh).transpose(0, 3, 1, 2, 4)

    q = heads(q, GLA_HK) * (GLA_HK ** -0.5)
    k = heads(k, GLA_HK)
    v = heads(v, GLA_HV)
    bcum = jnp.cumsum(heads(log_alpha, GLA_HK), axis=3)
    b_end = bcum[:, :, :, -1, :]
    q_dec = q * jnp.exp(bcum)
    k_dec = k * jnp.exp(-bcum)
    causal = jnp.tril(jnp.ones((GLA_CHUNK, GLA_CHUNK), dtype=bool))
    attn = jnp.where(causal, jnp.einsum('bhnik,bhnjk->bhnij', q_dec, k_dec), 0.0)
    o_intra = jnp.einsum('bhnij,bhnjv->bhniv', attn, v)
    k_end = k * jnp.exp(b_end[:, :, :, None, :] - bcum)
    chunk_kv = jnp.einsum('bhnjk,bhnjv->bhnkv', k_end, v)

    def step(state, inp):
        decay, kv = inp
        return decay[..., None] * state + kv, state

    s0 = jnp.zeros((B, GLA_HEADS, GLA_HK, GLA_HV), jnp.float32)
    _, states = lax.scan(step, s0, (jnp.moveaxis(jnp.exp(b_end), 2, 0), jnp.moveaxis(chunk_kv, 2, 0)))
    states = jnp.moveaxis(states, 0, 2)
    o = o_intra + jnp.einsum('bhnik,bhnkv->bhniv', q_dec, states)
    o = o.transpose(0, 2, 3, 1, 4).reshape(B, S, GLA_HEADS, GLA_HV)
    o = rms_norm(o, g_head.reshape(GLA_HEADS, GLA_HV)).reshape(B, S, GLA_DV)
    o = jax.nn.silu(r.astype(jnp.float32)) * o
    return o.astype(h.dtype) @ w_out


def sgu_mixer(h, w_in, ln_g, ln_b, w_s, b_s, w_out):
    B, S, _ = h.shape
    nc = S // SGU_CHUNK
    z = jax.nn.gelu(h @ w_in)
    u, v = jnp.split(z, 2, axis=-1)
    v = layer_norm(v, ln_g, ln_b).reshape(B, nc, SGU_CHUNK, SGU_GROUPS, SGU_GC)
    causal = jnp.tril(jnp.ones((SGU_CHUNK, SGU_CHUNK), dtype=bool))
    w_causal = jnp.where(causal, w_s, 0.0)
    s = jnp.einsum('gts,bnsgc->bntgc', w_causal, v) + jnp.transpose(b_s)[None, None, :, :, None]
    return (u * s.reshape(B, S, SGU_WIDTH)) @ w_out


def hier_moe(h, w_rg, b_rg, w_re, b_re, w_gate, w_up, w_down):
    f32 = jnp.float32
    group_logits = (h @ w_rg + b_rg).astype(f32)
    group_probs = jax.nn.softmax(group_logits, axis=-1)
    g_idx = jnp.argmax(group_logits, axis=-1)
    g_w = jnp.take_along_axis(group_probs, g_idx[..., None], axis=-1)
    expert_logits = (jnp.einsum('bsd,dge->bsge', h, w_re) + b_re).astype(f32)
    in_group = jnp.take_along_axis(expert_logits, g_idx[..., None, None], axis=2)[:, :, 0, :]
    top_vals, top_idx = lax.top_k(in_group, MOE_TOP_K)
    top_w = jax.nn.softmax(top_vals, axis=-1) * g_w
    expert_id = g_idx[..., None] * MOE_EXPERTS_PER_GROUP + top_idx
    combine = jnp.sum(jax.nn.one_hot(expert_id, MOE_N_EXPERTS, dtype=f32) * top_w[..., None],
                      axis=-2).astype(h.dtype)

    def per_row(args):
        hb, cb = args
        a = jnp.einsum('sd,edf->sef', hb, w_gate)
        b = jnp.einsum('sd,edf->sef', hb, w_up)
        act = jax.nn.silu(a) * b * cb[:, :, None]
        return jnp.einsum('sef,efd->sd', act, w_down)

    return lax.map(per_row, (h, combine))


def per_layer_embedding(hn, p_i, w_up, w_gate):
    return (p_i @ w_up) * jax.nn.sigmoid(hn @ w_gate)


def setup_inputs(seed: int = 0) -> dict:
    key = jax.random.key(seed)
    ks = jax.random.split(key, 26)

    def nrm(k, shape, scale):
        return jax.random.normal(k, shape, jnp.float32) * scale

    def gain(k, shape):
        return 1.0 + 0.02 * jax.random.normal(k, shape, jnp.float32)

    NA, NB, L, D = N_GLA_LAYERS, N_SGU_LAYERS, DEPTH, D_MODEL
    return {
        'x': nrm(ks[0], (BATCH, SEQ, D), 1.0),
        'p': nrm(ks[1], (DEPTH, BATCH, SEQ, PLE_DIM), 1.0),
        'gla_w_in': nrm(ks[2], (NA, D, GLA_IN), D ** -0.5),
        'gla_w_gate_up': nrm(ks[3], (NA, GLA_GATE_RANK, GLA_DK), GLA_GATE_RANK ** -0.5),
        'gla_b_gate': nrm(ks[4], (NA, GLA_DK), 0.1),
        'gla_g_head': gain(ks[5], (NA, GLA_DV)),
        'gla_w_out': nrm(ks[6], (NA, GLA_DV, D), GLA_DV ** -0.5),
        'sgu_w_in': nrm(ks[7], (NB, D, 2 * SGU_WIDTH), D ** -0.5),
        'sgu_ln_g': gain(ks[8], (NB, SGU_WIDTH)),
        'sgu_ln_b': nrm(ks[9], (NB, SGU_WIDTH), 0.02),
        'sgu_w_s': nrm(ks[10], (NB, SGU_GROUPS, SGU_CHUNK, SGU_CHUNK), 0.5 * SGU_CHUNK ** -0.5),
        'sgu_b_s': gain(ks[11], (NB, SGU_GROUPS, SGU_CHUNK)),
        'sgu_w_out': nrm(ks[12], (NB, SGU_WIDTH, D), SGU_WIDTH ** -0.5),
        'norm_mix_g': gain(ks[13], (L, D)),
        'norm_ffn_g': gain(ks[14], (L, D)),
        'norm_ple_g': gain(ks[15], (L, D)),
        'moe_w_route_group': nrm(ks[16], (L, D, MOE_GROUPS), D ** -0.5),
        'moe_b_route_group': nrm(ks[17], (L, MOE_GROUPS), 0.01),
        'moe_w_route_expert': nrm(ks[18], (L, D, MOE_GROUPS, MOE_EXPERTS_PER_GROUP), D ** -0.5),
        'moe_b_route_expert': nrm(ks[19], (L, MOE_GROUPS, MOE_EXPERTS_PER_GROUP), 0.01),
        'moe_w_gate': nrm(ks[20], (L, MOE_N_EXPERTS, D, MOE_FF), D ** -0.5),
        'moe_w_up': nrm(ks[21], (L, MOE_N_EXPERTS, D, MOE_FF), D ** -0.5),
        'moe_w_down': nrm(ks[22], (L, MOE_N_EXPERTS, MOE_FF, D), MOE_FF ** -0.5),
        'ple_w_up': nrm(ks[23], (L, PLE_DIM, D), PLE_DIM ** -0.5),
        'ple_w_gate': nrm(ks[24], (L, D, D), D ** -0.5),
        'final_norm_g': gain(ks[25], (D,)),
    }


def reference(x, p, gla_w_in, gla_w_gate_up, gla_b_gate, gla_g_head, gla_w_out,
              sgu_w_in, sgu_ln_g, sgu_ln_b, sgu_w_s, sgu_b_s, sgu_w_out,
              norm_mix_g, norm_ffn_g, norm_ple_g,
              moe_w_route_group, moe_b_route_group, moe_w_route_expert, moe_b_route_expert,
              moe_w_gate, moe_w_up, moe_w_down,
              ple_w_up, ple_w_gate, final_norm_g):
    h = x
    for i in range(DEPTH):
        j = i // N_MIXERS
        hn = rms_norm(h, norm_mix_g[i])
        if i % N_MIXERS == 0:
            h = h + gla_mixer(hn, gla_w_in[j], gla_w_gate_up[j], gla_b_gate[j],
                              gla_g_head[j], gla_w_out[j])
        else:
            h = h + sgu_mixer(hn, sgu_w_in[j], sgu_ln_g[j], sgu_ln_b[j],
                              sgu_w_s[j], sgu_b_s[j], sgu_w_out[j])
        h = h + hier_moe(rms_norm(h, norm_ffn_g[i]), moe_w_route_group[i], moe_b_route_group[i],
                         moe_w_route_expert[i], moe_b_route_expert[i],
                         moe_w_gate[i], moe_w_up[i], moe_w_down[i])
        h = h + per_layer_embedding(rms_norm(h, norm_ple_g[i]), p[i], ple_w_up[i], ple_w_gate[i])
    return rms_norm(h, final_norm_g)
```

```cpp
#include <hip/hip_runtime.h>
#include <stdint.h>
#include <stdio.h>

#define DEVI __device__ __forceinline__
#define LAS __attribute__((address_space(3)))
#ifndef USE_FAST
#define USE_FAST 1
#endif
#ifndef PROBE
#define PROBE 0
#endif
#define PB(k, stmt) do { stmt; if (PROBE == (k)) { __syncthreads(); stmt; } } while (0)
#define XBAR() do { xcd_barrier(bar); if (PROBE == 4) xcd_barrier(bar); } while (0)
typedef unsigned short bf16_t;
typedef short bf16x8 __attribute__((ext_vector_type(8)));
typedef float f32x4 __attribute__((ext_vector_type(4)));
typedef float f32x2 __attribute__((ext_vector_type(2)));
typedef unsigned u32x4 __attribute__((ext_vector_type(4)));
typedef unsigned u32x2 __attribute__((ext_vector_type(2)));

constexpr int T = 16384, D = 1024, SEQ = 2048, NLAYER = 4;
constexpr int GLA_IN = 3088, GLA_Z = 3072, HK = 128, HV = 256, GCH = 64, GNC = 32;
constexpr int SGU_Z = 4096, SGU_W = 2048, SGC = 256, SCH = 128, SNC = 16;
constexpr int NCLS = 24, FF = 512, PLE = 256;
constexpr float EPS = 1e-6f;
constexpr int NTHREADS = 512, NWAVES = 8;

constexpr size_t MiB = 1u << 20;
constexpr size_t WS_CTL = 0, CTL_BYTES = 1 * MiB;
constexpr size_t CTL_CNT = 131072;
constexpr int CNT_STRIDE = 64;
constexpr size_t CTL_BAR = 65536;
constexpr int LDS_STAGE = 0;
constexpr int LDS_SCHED = 131072;
constexpr int LDS_XB = 155632;
constexpr int LDS_BYTES = 155648;
constexpr size_t WS_TOKINFO = 1 * MiB;
constexpr size_t WS_LIST = 2 * MiB;
constexpr size_t WS_AGATE = 4 * MiB;
constexpr size_t WS_BEND = 5 * MiB;
constexpr size_t WS_WR = 6 * MiB;
constexpr size_t WS_SGUWS = 7 * MiB;
constexpr size_t WS_GLA_IN = 8 * MiB;
constexpr size_t WS_GLA_OUT = 21 * MiB;
constexpr size_t WS_SGU_IN = 25 * MiB;
constexpr size_t WS_SGU_OUT = 41 * MiB;
constexpr size_t WS_PLE_GATE = 49 * MiB;
constexpr size_t WS_PLE_UP = 57 * MiB;
constexpr size_t WS_MOE_UP = 60 * MiB;
constexpr size_t WS_MOE_DN = 92 * MiB;
constexpr size_t WS_UPLE = 108 * MiB;
constexpr size_t WS_HB0 = 172 * MiB;
constexpr size_t WS_HB1 = 204 * MiB;
constexpr size_t WS_ZBUF = 236 * MiB;
constexpr size_t WS_BUF2 = 364 * MiB;
constexpr size_t WS_PB = 428 * MiB;
constexpr size_t WS_SSQP = 436 * MiB;
constexpr size_t WS_LNP = 444 * MiB;
constexpr size_t WS_END = 452 * MiB;
constexpr size_t ZB_OB = (size_t)T * GLA_Z * 2;
constexpr size_t ZB_UPLE = 48 * MiB;
constexpr int ACT_ROWS = 88 * 256;

struct Params {
    const float* in[26];
    float* out;
    unsigned char* ws;
};
enum { I_X = 0, I_P, I_GLA_WIN, I_GLA_WGU, I_GLA_BG, I_GLA_GH, I_GLA_WOUT, I_SGU_WIN, I_SGU_LNG, I_SGU_LNB, I_SGU_WS, I_SGU_BS, I_SGU_WOUT,
       I_NMIX, I_NFFN, I_NPLE, I_WRG, I_BRG, I_WRE, I_BRE, I_MOE_WG, I_MOE_WU, I_MOE_WD, I_PLE_WUP, I_PLE_WG, I_FINAL };

DEVI int opaque_tid_(int wv) { int l; asm volatile("v_mbcnt_lo_u32_b32 %0, -1, 0\n\tv_mbcnt_hi_u32_b32 %0, -1, %0" : "=v"(l)); return (wv << 6) | l; }
#define opaque_tid() opaque_tid_(wv)
DEVI unsigned f2bf(float f) { unsigned u = __float_as_uint(f); return (u + 0x7fffu + ((u >> 16) & 1u)) >> 16; }
DEVI float bf2f(unsigned b) { return __uint_as_float(b << 16); }
DEVI unsigned pk2(float lo, float hi) { return f2bf(lo) | (f2bf(hi) << 16); }
DEVI float bflo(unsigned w) { return __uint_as_float(w << 16); }
DEVI float bfhi(unsigned w) { return __uint_as_float(w & 0xffff0000u); }
DEVI float wave_sum(float v) {
#pragma unroll
    for (int o = 1; o < 64; o <<= 1) v += __shfl_xor(v, o);
    return v;
}
DEVI float sigmoidf_(float x) { return __builtin_amdgcn_rcpf(1.0f + __expf(-x)); }
DEVI float siluf_(float x) { return x * sigmoidf_(x); }
DEVI float gelu_tanh(float x) {
    const float y = 0.7978845608028654f * (x + 0.044715f * x * x * x);
    return x * __builtin_amdgcn_rcpf(1.0f + __expf(-2.0f * y));
}
DEVI float logsigmoidf_(float x) { return fminf(x, 0.0f) - __logf(1.0f + __expf(-fabsf(x))); }
DEVI float rstd_from_ssq(float ssq) { return rsqrtf(ssq * (1.0f / D) + EPS); }
DEVI float rstd16s(const float* ssq, int row) {
    float v[16];
#pragma unroll
    for (int k = 0; k < 16; ++k) v[k] = ssq[(size_t)k * T + row];
    const float s = (((v[0] + v[1]) + (v[2] + v[3])) + ((v[4] + v[5]) + (v[6] + v[7]))) + (((v[8] + v[9]) + (v[10] + v[11])) + ((v[12] + v[13]) + (v[14] + v[15])));
    return rstd_from_ssq(s);
}
DEVI float rstd16(const float* p) {
    const f32x4 a = *(const f32x4*)p, b = *(const f32x4*)(p + 4), c = *(const f32x4*)(p + 8), d = *(const f32x4*)(p + 12);
    const float s = ((a.x + a.y) + (a.z + a.w)) + ((b.x + b.y) + (b.z + b.w)) + ((c.x + c.y) + (c.z + c.w)) + ((d.x + d.y) + (d.z + d.w));
    return rstd_from_ssq(s);
}

DEVI void tr_item(const float* W, int K, int N, const float* gain, bf16_t* WT, int k0, int n0, int nvalid, int rowbase, float* scr, int lane) {
    const int n = lane & 31, hi = lane >> 5;
    float v[32];
    const float gv = gain ? gain[k0 + lane] : 1.0f;
    const float* src = W + (size_t)(k0 + hi) * N + n0 + n;
#pragma unroll
    for (int i = 0; i < 32; ++i) v[i] = (n < nvalid) ? src[(size_t)(2 * i) * N] : 0.f;
#pragma unroll
    for (int i = 0; i < 32; ++i) scr[(2 * i + hi) * 33 + n] = v[i] * __shfl(gv, 2 * i + hi);
    asm volatile("s_waitcnt lgkmcnt(0)" ::: "memory");
    const int c = lane & 7;
#pragma unroll
    for (int j = 0; j < 4; ++j) {
        const int nn = (lane >> 3) + 8 * j; const float* sp = scr + (8 * c) * 33 + nn;
        u32x4 o; o.x = pk2(sp[0 * 33], sp[1 * 33]); o.y = pk2(sp[2 * 33], sp[3 * 33]); o.z = pk2(sp[4 * 33], sp[5 * 33]); o.w = pk2(sp[6 * 33], sp[7 * 33]);
        if (nn < nvalid) *(u32x4*)(WT + (size_t)(rowbase + nn) * K + k0 + 8 * c) = o;
    }
    asm volatile("s_waitcnt lgkmcnt(0)" ::: "memory");
}
DEVI void conv_mat(const float* W, int K, int N, const float* gain, bf16_t* WT, int mode, int& off, int gw, int ngw, float* scr, int lane) {
    const int nnb = (N + 31) / 32, nitems = (K / 64) * nnb;
    const int first = gw - off < 0 ? gw - off + ngw : gw - off;
    for (int it = first; it < nitems; it += ngw) {
        const int kb = it / nnb, nb = it % nnb, n0 = 32 * nb, nvalid = (N - n0) < 32 ? (N - n0) : 32;
        const int rowbase = mode == 0 ? n0 : ((n0 >> 7) * 256 + (n0 & 127) + (mode == 2 ? 128 : 0));
        tr_item(W, K, N, gain, WT, 64 * kb, n0, nvalid, rowbase, scr, lane);
    }
    off += nitems; while (off >= ngw) off -= ngw;
}

struct CvDesc { const float* W; const float* gain; bf16_t* WT; int K, N, k0, n0, nvalid, rowbase; };
DEVI bool cv_decode(const Params& P, int layer, int id, CvDesc& d) {
    unsigned char* ws = P.ws;
    const float* W; const float* gain = nullptr; bf16_t* WT; int K, N, mode = 0, it, sh;
    if (layer < 0) {
        if (id < 1552) { it = id; W = P.in[I_GLA_WIN]; gain = P.in[I_NMIX]; WT = (bf16_t*)(ws + WS_GLA_IN); K = D; N = GLA_IN; sh = 0; }
        else if (id < 2064) { it = id - 1552; W = P.in[I_GLA_WOUT]; WT = (bf16_t*)(ws + WS_GLA_OUT); K = D; N = D; sh = 5; }
        else return false;
    } else if (id < 12288) {
        const int e = id / 768, r = id - e * 768, kind = r >> 8; it = r & 255;
        if (kind < 2) { W = (kind == 0 ? P.in[I_MOE_WG] : P.in[I_MOE_WU]) + ((size_t)layer * 16 + e) * D * FF; gain = P.in[I_NFFN] + layer * D; WT = (bf16_t*)(ws + WS_MOE_UP) + (size_t)e * 1024 * 1024; K = D; N = FF; mode = 1 + kind; sh = 4; }
        else { W = P.in[I_MOE_WD] + ((size_t)layer * 16 + e) * FF * D; WT = (bf16_t*)(ws + WS_MOE_DN) + (size_t)e * 1024 * 512; K = FF; N = D; sh = 5; }
    } else if (id < 12800) { it = id - 12288; W = P.in[I_PLE_WG] + (size_t)layer * D * D; gain = P.in[I_NPLE] + layer * D; WT = (bf16_t*)(ws + WS_PLE_GATE) + (size_t)layer * D * D; K = D; N = D; sh = 5; }
    else if (id < 12928) { it = id - 12800; W = P.in[I_PLE_WUP] + (size_t)layer * PLE * D; WT = (bf16_t*)(ws + WS_PLE_UP) + (size_t)layer * D * PLE; K = PLE; N = D; sh = 5; }
    else {
        const int nl = layer + 1, j = nl >> 1, r = id - 12928;
        if (nl >= NLAYER) return false;
        if ((nl & 1) == 0) {
            if (r < 1552) { it = r; W = P.in[I_GLA_WIN] + (size_t)j * D * GLA_IN; gain = P.in[I_NMIX] + nl * D; WT = (bf16_t*)(ws + WS_GLA_IN) + (size_t)j * GLA_IN * D; K = D; N = GLA_IN; sh = 0; }
            else if (r < 2064) { it = r - 1552; W = P.in[I_GLA_WOUT] + (size_t)j * D * D; WT = (bf16_t*)(ws + WS_GLA_OUT) + (size_t)j * D * D; K = D; N = D; sh = 5; }
            else return false;
        } else {
            if (r < 2048) { it = r; W = P.in[I_SGU_WIN] + (size_t)j * D * SGU_Z; gain = P.in[I_NMIX] + nl * D; WT = (bf16_t*)(ws + WS_SGU_IN) + (size_t)j * SGU_Z * D; K = D; N = SGU_Z; sh = 7; }
            else if (r < 3072) { it = r - 2048; W = P.in[I_SGU_WOUT] + (size_t)j * SGU_W * D; WT = (bf16_t*)(ws + WS_SGU_OUT) + (size_t)j * D * SGU_W; K = SGU_W; N = D; sh = 5; }
            else return false;
        }
    }
    const int kb = sh ? (it >> sh) : it / 97, nb = it - kb * (sh ? (1 << sh) : 97), n0 = 32 * nb;
    d.W = W; d.gain = gain; d.WT = WT; d.K = K; d.N = N; d.k0 = 64 * kb; d.n0 = n0; d.nvalid = (N - n0) < 32 ? (N - n0) : 32;
    d.rowbase = mode == 0 ? n0 : ((n0 >> 7) * 256 + (n0 & 127) + (mode == 2 ? 128 : 0));
    return true;
}
DEVI void cv_load(const CvDesc& d, float (&v)[32], float& gv, int lane) {
    const int n = lane & 31, hi = lane >> 5;
    gv = d.gain ? d.gain[d.k0 + lane] : 1.0f;
    const float* src = d.W + (size_t)(d.k0 + hi) * d.N + d.n0 + (n < d.nvalid ? n : d.nvalid - 1);
#pragma unroll
    for (int i = 0; i < 32; ++i) v[i] = src[(size_t)(2 * i) * d.N];
}
DEVI void cv_store(const CvDesc& d, const float (&v)[32], float gv, float* scr, int lane) {
    const int n = lane & 31, hi = lane >> 5;
#pragma unroll
    for (int i = 0; i < 32; ++i) scr[(2 * i + hi) * 33 + n] = v[i] * __shfl(gv, 2 * i + hi);
    asm volatile("s_waitcnt lgkmcnt(0)" ::: "memory");
    const int c = lane & 7;
#pragma unroll
    for (int j = 0; j < 4; ++j) {
        const int nn = (lane >> 3) + 8 * j; const float* sp = scr + (8 * c) * 33 + nn;
        u32x4 o; o.x = pk2(sp[0 * 33], sp[1 * 33]); o.y = pk2(sp[2 * 33], sp[3 * 33]); o.z = pk2(sp[4 * 33], sp[5 * 33]); o.w = pk2(sp[6 * 33], sp[7 * 33]);
        if (nn < d.nvalid) *(u32x4*)(d.WT + (size_t)(d.rowbase + nn) * d.K + d.k0 + 8 * c) = o;
    }
    asm volatile("s_waitcnt lgkmcnt(0)" ::: "memory");
}
DEVI void cv_run(const Params& P, int layer, int gw, int ngw, float* scr, int lane) {
    CvDesc da, db; float va[32], vb[32], ga = 1.0f, gb = 1.0f;
    int id = gw;
    bool ha = cv_decode(P, layer, id, da);
    if (ha) cv_load(da, va, ga, lane);
    while (ha) {
        id += ngw; const bool hb = cv_decode(P, layer, id, db); if (hb) cv_load(db, vb, gb, lane);
        cv_store(da, va, ga, scr, lane);
        if (!hb) break;
        id += ngw; ha = cv_decode(P, layer, id, da); if (ha) cv_load(da, va, ga, lane);
        cv_store(db, vb, gb, scr, lane);
    }
}

DEVI void phase_prologue(const Params& P, int wv, int vc, unsigned char* lds) {
    const int tid = opaque_tid(), lane = tid & 63, wave = wv;
    const int gw = vc * NWAVES + wave, ngw = gridDim.x * NWAVES;
    float* scr = (float*)(lds + wave * 8704);
    unsigned char* ws = P.ws;
    const float* x = P.in[I_X]; f32x4 v[8][4];
#pragma unroll
    for (int q = 0; q < 4; ++q) { const int row = gw + q * ngw; const f32x4* xr = (const f32x4*)(x + (size_t)(row < T ? row : 0) * D) + lane;
#pragma unroll
        for (int j = 0; j < 4; ++j) v[q][j] = xr[64 * j]; }
    cv_run(P, -1, gw, ngw, scr, lane);
    {
        const float* src = P.in[I_SGU_WS]; bf16_t* dst = (bf16_t*)(ws + WS_SGUWS);
        for (int idx = vc * NTHREADS + tid; idx < 2 * 8 * 128 * 128; idx += gridDim.x * NTHREADS) {
            const int s = idx & 127, t = (idx >> 7) & 127;
            dst[idx] = (bf16_t)f2bf(s <= t ? src[idx] : 0.f);
        }
    }
    {
        bf16_t* wr = (bf16_t*)(ws + WS_WR);
        for (int idx = vc * NTHREADS + tid; idx < NLAYER * 32 * D; idx += gridDim.x * NTHREADS) {
            const int k = idx % D, o = (idx / D) % 32, l = idx / (32 * D);
            float w = 0.f;
            if (o < 20) { const float g = P.in[I_NFFN][l * D + k]; w = g * ((o < 4) ? P.in[I_WRG][((size_t)l * D + k) * 4 + o] : P.in[I_WRE][((size_t)l * D + k) * 16 + (o - 4)]); }
            const unsigned hi = f2bf(w); const unsigned lo = f2bf(w - bf2f(hi));
            wr[((size_t)(l * 2 + 0) * 32 + o) * D + k] = (bf16_t)hi; wr[((size_t)(l * 2 + 1) * 32 + o) * D + k] = (bf16_t)lo;
        }
    }
    {
        bf16_t* hb0 = (bf16_t*)(ws + WS_HB0); float* ssq = (float*)(ws + WS_SSQP);
        for (int row0 = gw; row0 < T; row0 += 8 * ngw) {
#pragma unroll
            for (int q = 4; q < 8; ++q) { const int row = row0 + q * ngw; const f32x4* xr = (const f32x4*)(x + (size_t)(row < T ? row : 0) * D) + lane;
#pragma unroll
                for (int j = 0; j < 4; ++j) v[q][j] = xr[64 * j]; }
            if (row0 != gw) {
#pragma unroll
                for (int q = 0; q < 4; ++q) { const int row = row0 + q * ngw; const f32x4* xr = (const f32x4*)(x + (size_t)(row < T ? row : 0) * D) + lane;
#pragma unroll
                    for (int j = 0; j < 4; ++j) v[q][j] = xr[64 * j]; }
            }
#pragma unroll
            for (int q = 0; q < 8; ++q) {
                const int row = row0 + q * ngw; if (row < T) {
                float s = 0.f;
#pragma unroll
                for (int j = 0; j < 4; ++j) {
                    const f32x4 w = v[q][j];
                    s += w.x * w.x + w.y * w.y + w.z * w.z + w.w * w.w;
                    u32x2 o; o.x = pk2(w.x, w.y); o.y = pk2(w.z, w.w);
                    *(u32x2*)(hb0 + (size_t)row * D + 4 * lane + 256 * j) = o;
                }
                s = wave_sum(s);
                if (lane < 16) ssq[(size_t)lane * T + row] = lane == 0 ? s : 0.f;
                }
            }
        }
    }
}

DEVI void phase_layer_pre(const Params& P, int wv, int vc, unsigned char* lds, int layer) {
    const int tid = opaque_tid(), lane = tid & 63, wave = wv;
    const int gw = vc * NWAVES + wave, ngw = gridDim.x * NWAVES;
    float* scr = (float*)(lds + wave * 8704);
    unsigned char* ws = P.ws;
    cv_run(P, layer, gw, ngw, scr, lane);
    const float* p = P.in[I_P] + (size_t)layer * T * PLE; bf16_t* pb = (bf16_t*)(ws + WS_PB);
    {
        const size_t stride = (size_t)gridDim.x * NTHREADS, i0 = (size_t)vc * NTHREADS + tid, nq = (size_t)T * PLE / 4;
        for (size_t base = i0; base < nq; base += 8 * stride) {
            f32x4 v[8];
#pragma unroll
            for (int j = 0; j < 8; ++j) { const size_t idx = base + j * stride; v[j] = idx < nq ? ((const f32x4*)p)[idx] : (f32x4){0.f, 0.f, 0.f, 0.f}; }
#pragma unroll
            for (int j = 0; j < 8; ++j) { const size_t idx = base + j * stride; if (idx < nq) { u32x2 o; o.x = pk2(v[j].x, v[j].y); o.y = pk2(v[j].z, v[j].w); ((u32x2*)pb)[idx] = o; } }
        }
    }
}

struct Unit {
    int pm, pn;
    const bf16_t* A;
    const LAS int* rows;
    int nvalid;
    const bf16_t* B0;
    const bf16_t* B1;
    int aux0, aux1;
    int idx;
};
struct GemmShape { int lda, ldb, K, ksplit; bool gatherA; };
constexpr int NXCD = 8, WGM = 8;
struct PlainSched {
    const bf16_t* A; const bf16_t* Bt; int lda, ldb; int nM, nN, nwg, G, c;
    DEVI void init(const bf16_t* A_, int lda_, const bf16_t* Bt_, int ldb_, int M, int N, int G_, int c_) { A = A_; Bt = Bt_; lda = lda_; ldb = ldb_; nM = M / 256; nN = N / 256; nwg = nM * nN; G = G_; c = c_; }
    DEVI bool next(int i, Unit& u) const {
        const long L = (long)i * G + c; if (L >= nwg) return false;
        int wgid = (int)L; { const int q = nwg / NXCD, r = nwg % NXCD, xcd = wgid % NXCD, off = wgid / NXCD; wgid = (xcd < r ? xcd * (q + 1) : r * (q + 1) + (xcd - r) * q) + off; }
        const int nig = WGM * nN, gid = wgid / nig, fm = gid * WGM, gsz = (nM - fm) < WGM ? (nM - fm) : WGM;
        u.pm = fm + ((wgid % nig) % gsz); u.pn = (wgid % nig) / gsz;
        u.A = A + (size_t)u.pm * 256 * lda; u.rows = nullptr; u.nvalid = 256; u.B0 = Bt + (size_t)u.pn * 256 * ldb; u.B1 = u.B0; u.aux0 = 0; u.aux1 = 0; u.idx = i;
        return true;
    }
};
constexpr int LDS_RTAB = LDS_SCHED + 8192;
struct NoHook { DEVI void operator()() const {} };
template <class Sched> struct RstdHook {
    int wv; unsigned char* lds; const Sched* S; const float* ssq;
    DEVI void operator()() const {
        const int tid = opaque_tid();
        LAS float* rtab = (LAS float*)((LAS unsigned char*)lds + LDS_RTAB);
        const int half = __builtin_amdgcn_readfirstlane(tid >> 8), r = tid & 255;
        float v[2]; bool ok[2];
#pragma unroll
        for (int i2 = 0; i2 < 2; ++i2) { Unit u; ok[i2] = S->next(2 * i2 + half, u); v[i2] = ok[i2] ? rstd16s(ssq, u.pm * 256 + r) : 0.f; }
#pragma unroll
        for (int i2 = 0; i2 < 2; ++i2) if (ok[i2]) rtab[(2 * i2 + half) * 256 + r] = v[i2];
    }
};
template <class Sched> DEVI void rstd_table_setup(int wv, unsigned char* lds, const Sched& S, const float* ssq) {
    const int tid = opaque_tid();
    LAS float* rtab = (LAS float*)((LAS unsigned char*)lds + LDS_RTAB);
    __syncthreads();
    const int half = __builtin_amdgcn_readfirstlane(tid >> 8), r = tid & 255;
    float v[2]; bool ok[2];
#pragma unroll
    for (int i2 = 0; i2 < 2; ++i2) { Unit u; ok[i2] = S.next(2 * i2 + half, u); v[i2] = ok[i2] ? rstd16s(ssq, u.pm * 256 + r) : 0.f; }
#pragma unroll
    for (int i2 = 0; i2 < 2; ++i2) if (ok[i2]) rtab[(2 * i2 + half) * 256 + r] = v[i2];
    __syncthreads();
}
DEVI void cls_experts(int cl, int& e1, int& e2) { const int g = cl / 6, p = cl % 6; const int a = p < 3 ? 0 : (p < 5 ? 1 : 2); const int b = p < 3 ? p + 1 : (p < 5 ? p - 1 : 3); e1 = g * 4 + a; e2 = g * 4 + b; }
DEVI int moe_find_cls(const LAS int* pre, int rt) { int cl = 0;
#pragma unroll 1
    for (int k = 1; k < NCLS; ++k) if (pre[k] <= rt) cl = k;
    return cl; }
struct MoeSched {
    const LAS int* pre; const LAS int* cnt; const LAS int* rowsl; int ncol, G, c; bool up; const bf16_t* A; const bf16_t* W;
    DEVI bool next(int i, Unit& u) const {
        if (i >= 4) return false;
        const LAS int* ud = pre + 1088 + 4 * i;
        const int rt = ud[0]; if (rt < 0) return false;
        const int pn = ud[1], cl = ud[2];
        u.pm = rt; u.pn = pn; u.rows = rowsl + i * 256; u.nvalid = ud[3]; u.idx = i;
        int e1, e2; cls_experts(cl, e1, e2);
        if (up) { const int which = pn >> 2; const int e = which ? e2 : e1; u.A = A; u.B0 = W + ((size_t)e * 1024 + (pn & 3) * 256) * 1024; u.B1 = u.B0; u.aux0 = rt * 256; u.aux1 = which; }
        else { u.A = A + (size_t)rt * 256 * 1024; u.B0 = W + ((size_t)e1 * 1024 + pn * 256) * 512; u.B1 = W + ((size_t)e2 * 1024 + pn * 256) * 512; u.aux0 = rt * 256; u.aux1 = 0; }
        return true;
    }
};
enum { MOE_UP_A = 0, MOE_UP_B, MOE_DN_B, MOE_DN_C };
DEVI int moe_sched_setup(const Params& P, int wv, int vc, int layer, LAS int* lds_pre, LAS int* lds_cnt, LAS int* rowsl, int ncol, int mode, bool grp) {
    const int* cnt = (const int*)(P.ws + CTL_CNT) + layer * 32 * CNT_STRIDE; const int* list = (const int*)(P.ws + WS_LIST);
    const int tid = opaque_tid();
    __syncthreads();
    if (mode == MOE_UP_A && tid < 32) {
        const int n = tid < NCLS ? cnt[tid * CNT_STRIDE] : 0; const int tl = (n + 255) >> 8; int x = tl;
#pragma unroll
        for (int o = 1; o < 32; o <<= 1) { const int y = __shfl_up(x, o); if (tid >= o) x += y; }
        if (tid < NCLS) { lds_cnt[tid] = n; lds_pre[tid] = x - tl; }
        if (tid == NCLS - 1) lds_pre[NCLS] = x;
    }
    __syncthreads();
    int ntile = lds_pre[NCLS], G = (int)gridDim.x, c = vc, rt0 = 0;
    if (grp) { const int x = vc & 7, q = ntile >> 3, rem = ntile & 7; G >>= 3; c = vc >> 3; rt0 = x * q + (x < rem ? x : rem); ntile = q + (x < rem ? 1 : 0); }
    const int n2 = 8 * ntile, n3 = 4 * ntile;
    const int nA = n2 < 2 * G ? n2 : 2 * G, nB = n2 - nA;
    const int wB = nB < G ? nB : G;
    const int dB = (G - wB) < n3 ? (G - wB) : n3;
    int L0, N, c_off, Gx;
    if (mode == MOE_UP_A) { L0 = 0; N = nA; c_off = 0; Gx = G; }
    else if (mode == MOE_UP_B) { L0 = nA; N = nB; c_off = 0; Gx = wB > 0 ? wB : 1; }
    else if (mode == MOE_DN_B) { L0 = 0; N = dB; c_off = wB; Gx = (G - wB) > 0 ? (G - wB) : 1; }
    else { L0 = dB; N = n3 - dB; c_off = 0; Gx = G; }
    const int my = c - c_off;
    const int lane = tid & 63;
    const int pre_l = lds_pre[lane < NCLS ? lane : NCLS];
    int cl_[4], tt_[4], nv_[4]; bool ok_[4];
#pragma unroll
    for (int i = 0; i < 4; ++i) {
        const int L = L0 + my + i * Gx;
        ok_[i] = !(my < 0 || my >= Gx || L >= L0 + N);
        const int rt = rt0 + (ok_[i] ? L / ncol : 0);
        const unsigned long long m = __ballot(lane < NCLS && pre_l <= rt);
        const int cl = __popcll(m) - 1;
        const int tt = rt - lds_pre[cl]; int nv = lds_cnt[cl] - 256 * tt; nv = nv < 256 ? nv : 256;
        cl_[i] = cl; tt_[i] = tt; nv_[i] = nv;
        if (tid == 0) { lds_pre[1088 + 4 * i] = ok_[i] ? rt : -1; lds_pre[1089 + 4 * i] = L % ncol; lds_pre[1090 + 4 * i] = cl; lds_pre[1091 + 4 * i] = nv; }
    }
    (void)tt_; (void)list; (void)rowsl;
    __syncthreads();
    return N;
}
struct MoeListHook {
    int wv; const LAS int* pre; const LAS int* cnt_; LAS int* rowsl; const int* list; bool sync;
    DEVI void operator()() const {
        const int tid = opaque_tid(), hsel = __builtin_amdgcn_readfirstlane(tid >> 8), r = tid & 255; int v[2];
#pragma unroll
        for (int i2 = 0; i2 < 2; ++i2) {
            const LAS int* ud = pre + 1088 + 4 * (2 * i2 + hsel);
            const int rt = ud[0], cl = ud[2], nv = ud[3]; const bool ok = rt >= 0;
            const int tt = rt - pre[ok ? cl : 0];
            v[i2] = ok ? list[(size_t)cl * T + 256 * tt + (r < nv ? r : nv - 1)] : 0;
        }
#pragma unroll
        for (int i2 = 0; i2 < 2; ++i2) rowsl[(2 * i2 + hsel) * 256 + r] = v[i2];
        if (sync) __syncthreads();
    }
};

DEVI int perm32(int rho) { const int n = rho >> 4, i = rho & 15; return 8 * (i >> 2) + 4 * n + (i & 3); }
DEVI int unit_row(const Unit& u, int r) { return u.rows ? u.rows[r] : u.pm * 256 + r; }
DEVI bool unit_valid(const Unit& u, int r) { return !u.rows || r < u.nvalid; }

typedef __bf16 bf16x2_t __attribute__((ext_vector_type(2)));
DEVI unsigned pk4_fp8(float a, float b, float c, float d) {
    a = __builtin_amdgcn_fmed3f(a, -224.f, 224.f); b = __builtin_amdgcn_fmed3f(b, -224.f, 224.f); c = __builtin_amdgcn_fmed3f(c, -224.f, 224.f); d = __builtin_amdgcn_fmed3f(d, -224.f, 224.f);
    int w = 0; w = __builtin_amdgcn_cvt_pk_fp8_f32(a, b, w, false); w = __builtin_amdgcn_cvt_pk_fp8_f32(c, d, w, true); return (unsigned)w;
}
DEVI f32x2 fp8lo2(unsigned w) { return __builtin_amdgcn_cvt_pk_f32_fp8((int)w, false); }
DEVI f32x2 fp8hi2(unsigned w) { return __builtin_amdgcn_cvt_pk_f32_fp8((int)w, true); }
DEVI unsigned cvt_pk_bf16(float lo, float hi) { const bf16x2_t v = __builtin_convertvector((f32x2){lo, hi}, bf16x2_t); return __builtin_bit_cast(unsigned, v); }

DEVI f32x2 gelu_tanh2(f32x2 x) {
    const f32x2 x2 = x * x;
    const f32x2 t = x * (x2 * (-2.0f * 1.4426950408889634f * 0.7978845608028654f * 0.044715f) + (-2.0f * 1.4426950408889634f * 0.7978845608028654f));
    f32x2 e; e.x = __builtin_amdgcn_exp2f(t.x); e.y = __builtin_amdgcn_exp2f(t.y);
    const f32x2 d = e + 1.0f;
    f32x2 r; r.x = __builtin_amdgcn_rcpf(d.x); r.y = __builtin_amdgcn_rcpf(d.y);
    return x * r;
}
DEVI f32x2 sigmoid2(f32x2 x) {
    const f32x2 t = x * (-1.4426950408889634f);
    f32x2 e; e.x = __builtin_amdgcn_exp2f(t.x); e.y = __builtin_amdgcn_exp2f(t.y);
    const f32x2 d = e + 1.0f;
    f32x2 r; r.x = __builtin_amdgcn_rcpf(d.x); r.y = __builtin_amdgcn_rcpf(d.y);
    return r;
}
DEVI u32x4 xchg8(u32x4 v) { u32x4 r; r.x = __shfl_xor(v.x, 8); r.y = __shfl_xor(v.y, 8); r.z = __shfl_xor(v.z, 8); r.w = __shfl_xor(v.w, 8); return r; }
DEVI u32x4 sel4(bool c, u32x4 a, u32x4 b) { u32x4 r; r.x = c ? a.x : b.x; r.y = c ? a.y : b.y; r.z = c ? a.z : b.z; r.w = c ? a.w : b.w; return r; }
template <bool F8>
struct EpiZT {
    static constexpr bool PERM = true, CMAP = true;
    bf16_t* O; int ldc; const LAS float* ssq; int act; float* lnstat; int stat_pn0;
    DEVI void operator()(const f32x4 (&acc)[2][2][4][2], const Unit& u, int wr, int wc, int fr, int fq) const {
        const bool st = act == 1 && u.pn >= stat_pn0;
        const bool lo = fr < 8;
        const int colx = u.pn * 256 + 64 * wc + (lo ? 0 : 32) + 8 * fq;
#pragma unroll
        for (int ai = 0; ai < 2; ++ai)
#pragma unroll
            for (int m = 0; m < 4; ++m) {
                const int rloc = ai * 128 + wr * 64 + m * 16;
                const int row = u.pm * 256 + rloc + fr;
                const float rs = ssq ? ssq[u.idx * 256 + rloc + fr] : 1.0f;
                f32x2 sv1 = (f32x2){0.f, 0.f}, sv2 = (f32x2){0.f, 0.f};
                u32x4 Pz[2]; f32x2 Pf[2][4];
#pragma unroll
                for (int bj = 0; bj < 2; ++bj) {
                    f32x2 v2[4];
#pragma unroll
                    for (int n = 0; n < 2; ++n)
#pragma unroll
                        for (int e = 0; e < 2; ++e) {
                            f32x2 x = (f32x2){acc[ai][bj][m][n][2 * e], acc[ai][bj][m][n][2 * e + 1]} * rs;
                            if (st) x = gelu_tanh2(x);
                            v2[2 * n + e] = x; if (st) { sv1 += x; sv2 += x * x; }
                        }
                    Pz[bj].x = cvt_pk_bf16(v2[0].x, v2[0].y); Pz[bj].y = cvt_pk_bf16(v2[1].x, v2[1].y); Pz[bj].z = cvt_pk_bf16(v2[2].x, v2[2].y); Pz[bj].w = cvt_pk_bf16(v2[3].x, v2[3].y);
#pragma unroll
                    for (int q4 = 0; q4 < 4; ++q4) Pf[bj][q4] = v2[q4];
                }
                if (F8) {
                    u32x2 P8[2];
#pragma unroll
                    for (int bj = 0; bj < 2; ++bj) { P8[bj].x = pk4_fp8(Pf[bj][0].x, Pf[bj][0].y, Pf[bj][1].x, Pf[bj][1].y); P8[bj].y = pk4_fp8(Pf[bj][2].x, Pf[bj][2].y, Pf[bj][3].x, Pf[bj][3].y); }
                    const bool ev = (fq & 1) == 0;
                    const u32x2 snd = ev ? P8[1] : P8[0];
                    u32x2 rc; rc.x = __shfl_xor(snd.x, 16); rc.y = __shfl_xor(snd.y, 16);
                    const u32x4 o16 = ev ? (u32x4){P8[0].x, P8[0].y, rc.x, rc.y} : (u32x4){rc.x, rc.y, P8[1].x, P8[1].y};
                    const int col8 = u.pn * 256 + 64 * wc + (ev ? 0 : 32) + 16 * (fq >> 1);
                    *(u32x4*)((unsigned char*)O + (size_t)row * ldc + col8) = o16;
                } else {
                const u32x4 rcv = xchg8(sel4(lo, Pz[1], Pz[0]));
                const size_t rowA = (size_t)(u.pm * 256 + rloc + (fr & 7));
                *(u32x4*)(O + rowA * ldc + colx) = sel4(lo, Pz[0], rcv);
                *(u32x4*)(O + (rowA + 8) * ldc + colx) = sel4(lo, rcv, Pz[1]);
                }
                if (st) {
                    float s1 = sv1.x + sv1.y, s2 = sv2.x + sv2.y;
                    s1 += __shfl_xor(s1, 16); s1 += __shfl_xor(s1, 32); s2 += __shfl_xor(s2, 16); s2 += __shfl_xor(s2, 32);
                    if (fq == 0) *(f32x2*)(lnstat + ((size_t)row * 32 + (u.pn - stat_pn0) * 4 + wc) * 2) = (f32x2){s1, s2};
                }
            }
    }
};
typedef EpiZT<false> EpiZ;
struct EpiAct {
    static constexpr bool PERM = true, CMAP = false;
    bf16_t* act; const f32x4* tokinfo;
    DEVI void operator()(const f32x4 (&acc)[2][2][4][2], const Unit& u, int wr, int wc, int fr, int fq) const {
        f32x4 infos[8];
#pragma unroll
        for (int it = 0; it < 8; ++it) infos[it] = tokinfo[unit_row(u, (it >> 2) * 128 + wr * 64 + (it & 3) * 16 + fr)];
#pragma unroll
        for (int ai = 0; ai < 2; ++ai)
#pragma unroll
            for (int m = 0; m < 4; ++m) {
                const int r = ai * 128 + wr * 64 + m * 16 + fr;
                const f32x4 info = infos[ai * 4 + m];
                const float rs = info.x, w = u.aux1 ? info.z : info.y;
                f32x2 v2[4]; const float rsw = rs * w;
#pragma unroll
                for (int n = 0; n < 2; ++n)
#pragma unroll
                    for (int e = 0; e < 2; ++e) {
                        const f32x2 g = (f32x2){acc[ai][0][m][n][2 * e], acc[ai][0][m][n][2 * e + 1]} * rs, up = (f32x2){acc[ai][1][m][n][2 * e], acc[ai][1][m][n][2 * e + 1]} * rsw;
                        v2[2 * n + e] = g * sigmoid2(g) * up;
                    }
                u32x4 o; o.x = cvt_pk_bf16(v2[0].x, v2[0].y); o.y = cvt_pk_bf16(v2[1].x, v2[1].y); o.z = cvt_pk_bf16(v2[2].x, v2[2].y); o.w = cvt_pk_bf16(v2[3].x, v2[3].y);
                *(u32x4*)(act + (size_t)(u.aux0 + r) * 1024 + u.aux1 * 512 + (u.pn & 3) * 128 + wc * 32 + 8 * fq) = o;
            }
    }
};
template <bool UP>
struct EpiRes {
    static constexpr bool PERM = true, CMAP = true;
    static constexpr int NB = UP ? 2 : 4;
    const bf16_t* hin; bf16_t* hout; float* ssq_out; const bf16_t* uple; const LAS float* ssq_in;
    DEVI void operator()(const f32x4 (&acc)[2][2][4][2], const Unit& u, int wr, int wc, int fr, int fq) const {
        asm volatile("" : "+v"(fr), "+v"(fq));
        const bool lo = fr < 8;
        const int colx = u.pn * 256 + 64 * wc + (lo ? 0 : 32) + 8 * fq;
        u32x4 hb[NB][2], ub[UP ? NB : 1][2];
#pragma unroll
        for (int it = 0; it < NB; ++it) {
            const int rA = (it >> 2) * 128 + wr * 64 + (it & 3) * 16 + (fr & 7);
            const size_t offA = (size_t)unit_row(u, rA) * D + colx, offB = (size_t)unit_row(u, rA + 8) * D + colx;
            hb[it][0] = *(const u32x4*)(hin + offA); hb[it][1] = *(const u32x4*)(hin + offB);
            if (UP) { ub[it][0] = *(const u32x4*)(uple + offA); ub[it][1] = *(const u32x4*)(uple + offB); }
        }
#pragma unroll
        for (int it = 0; it < 8; ++it) {
            const int ai = it >> 2, m = it & 3, sl = it % NB;
            const int rloc = ai * 128 + wr * 64 + m * 16, r = rloc + fr, rA = rloc + (fr & 7), rB = rA + 8;
            const size_t offA = (size_t)unit_row(u, rA) * D + colx, offB = (size_t)unit_row(u, rB) * D + colx;
            const bool okA = unit_valid(u, rA), okB = unit_valid(u, rB);
            const u32x4 hr = xchg8(sel4(lo, hb[sl][1], hb[sl][0]));
            const u32x4 hme[2] = {sel4(lo, hb[sl][0], hr), sel4(lo, hr, hb[sl][1])};
            u32x4 ume[2];
            if (UP) { const u32x4 ur = xchg8(sel4(lo, ub[sl][1], ub[sl][0])); ume[0] = sel4(lo, ub[sl][0], ur); ume[1] = sel4(lo, ur, ub[sl][1]); }
            if (it + NB < 8) {
                const int rN = ((it + NB) >> 2) * 128 + wr * 64 + ((it + NB) & 3) * 16 + (fr & 7);
                const size_t onA = (size_t)unit_row(u, rN) * D + colx, onB = (size_t)unit_row(u, rN + 8) * D + colx;
                hb[sl][0] = *(const u32x4*)(hin + onA); hb[sl][1] = *(const u32x4*)(hin + onB);
                if (UP) { ub[sl][0] = *(const u32x4*)(uple + onA); ub[sl][1] = *(const u32x4*)(uple + onB); }
            }
            const float rs = UP ? ssq_in[u.idx * 256 + r] : 1.0f;
            float s2 = 0.f; u32x4 Po[2];
#pragma unroll
            for (int bj = 0; bj < 2; ++bj) {
                float a[8];
#pragma unroll
                for (int n = 0; n < 2; ++n)
#pragma unroll
                    for (int e = 0; e < 4; ++e) a[4 * n + e] = acc[ai][bj][m][n][e];
                if (UP) {
                    const unsigned ua[4] = {ume[bj].x, ume[bj].y, ume[bj].z, ume[bj].w};
#pragma unroll
                    for (int j = 0; j < 4; ++j) { const f32x2 sg = sigmoid2((f32x2){a[2 * j], a[2 * j + 1]} * rs); a[2 * j] = bflo(ua[j]) * sg.x; a[2 * j + 1] = bfhi(ua[j]) * sg.y; }
                }
                const unsigned ha[4] = {hme[bj].x, hme[bj].y, hme[bj].z, hme[bj].w}; unsigned o[4];
#pragma unroll
                for (int j = 0; j < 4; ++j) { o[j] = cvt_pk_bf16(bflo(ha[j]) + a[2 * j], bfhi(ha[j]) + a[2 * j + 1]); const float o0 = bflo(o[j]), o1 = bfhi(o[j]); s2 += o0 * o0 + o1 * o1; }
                Po[bj] = (u32x4){o[0], o[1], o[2], o[3]};
            }
            const u32x4 orv = xchg8(sel4(lo, Po[1], Po[0]));
            if (okA) *(u32x4*)(hout + offA) = sel4(lo, Po[0], orv);
            if (okB) *(u32x4*)(hout + offB) = sel4(lo, orv, Po[1]);
            if (ssq_out) { s2 += __shfl_xor(s2, 16); s2 += __shfl_xor(s2, 32); if (fq == 0 && unit_valid(u, r)) ssq_out[(size_t)(u.pn * 4 + wc) * T + unit_row(u, r)] = s2; }
        }
    }
};

template <class Epi, class Sched>
DEVI void gemm_simple(int wv, const GemmShape g, const Sched& S, const Epi& E) {
    const int tid = opaque_tid(), wid = tid >> 6, lane = tid & 63, wr = wid >> 2, wc = wid & 3, fr = lane & 15, fq = lane >> 4;
    Unit u;
    for (int i = 0; S.next(i, u); ++i) {
        f32x4 acc[2][2][4][2];
#pragma unroll
        for (int a = 0; a < 2; ++a)
#pragma unroll
            for (int b = 0; b < 2; ++b)
#pragma unroll
                for (int m = 0; m < 4; ++m)
#pragma unroll
                    for (int n = 0; n < 2; ++n) acc[a][b][m][n] = (f32x4){0.f, 0.f, 0.f, 0.f};
        const bf16_t* ap[2][4];
#pragma unroll
        for (int ai = 0; ai < 2; ++ai)
#pragma unroll
            for (int m = 0; m < 4; ++m) {
                const int r = ai * 128 + wr * 64 + m * 16 + fr;
                const size_t grow = g.gatherA ? (size_t)u.rows[r] : (size_t)r;
                ap[ai][m] = u.A + grow * g.lda + 8 * fq;
            }
        size_t boff[2][2];
#pragma unroll
        for (int bj = 0; bj < 2; ++bj)
#pragma unroll
            for (int n = 0; n < 2; ++n) {
                const int c = Epi::CMAP ? (64 * wc + 32 * bj + perm32(16 * n + fr)) : (bj * 128 + wc * 32 + (Epi::PERM ? perm32(16 * n + fr) : 16 * n + fr));
                boff[bj][n] = (size_t)c * g.ldb + 8 * fq;
            }
        for (int k0 = 0; k0 < g.K; k0 += 32) {
            const bf16_t* bb = k0 < g.ksplit ? u.B0 + k0 : u.B1 + (k0 - g.ksplit);
            bf16x8 Af[2][4], Bf[2][2];
#pragma unroll
            for (int ai = 0; ai < 2; ++ai)
#pragma unroll
                for (int m = 0; m < 4; ++m) Af[ai][m] = *(const bf16x8*)(ap[ai][m] + k0);
#pragma unroll
            for (int bj = 0; bj < 2; ++bj)
#pragma unroll
                for (int n = 0; n < 2; ++n) Bf[bj][n] = *(const bf16x8*)(bb + boff[bj][n]);
#pragma unroll
            for (int ai = 0; ai < 2; ++ai)
#pragma unroll
                for (int bj = 0; bj < 2; ++bj)
#pragma unroll
                    for (int m = 0; m < 4; ++m)
#pragma unroll
                        for (int n = 0; n < 2; ++n) acc[ai][bj][m][n] = __builtin_amdgcn_mfma_f32_16x16x32_bf16(Bf[bj][n], Af[ai][m], acc[ai][bj][m][n], 0, 0, 0);
        }
        E(acc, u, wr, wc, fr, fq);
    }
}

constexpr int HTB = 128 * 64 * 2;
DEVI int lds_byte(int r, int c) { const int st = (r >> 4) * 2 + (c >> 5), rr = r & 15, cc = c & 31, ob = rr * 64 + cc * 2; return st * 1024 + (ob ^ (((ob >> 9) & 1) << 5)); }
DEVI void stage_rc(int b, int& R, int& C) { const int st = b / 1024, sb = b % 1024, swz = sb ^ (((sb >> 9) & 1) << 5); R = (st >> 1) * 16 + swz / 64; C = (st & 1) * 32 + (swz % 64) / 2; }
template <bool GATHER, class Epi, class Sched, class Hook, class PreA>
DEVI void gemm_fast(int wv, LAS unsigned char* lds, const GemmShape g, const Sched& S, const Epi& E, const Hook& hook, const PreA& prea) {
    const int tid = opaque_tid(), wid = __builtin_amdgcn_readfirstlane(tid >> 6), lane = tid & 63, wr = wid >> 2, wc = wid & 3, fr = lane & 15, fq = lane >> 4;
    const int nt = g.K / 64;
    int sR[2], sC[2]; unsigned voffB[2];
#pragma unroll
    for (int i = 0; i < 2; ++i) { stage_rc(tid * 16 + i * 8192, sR[i], sC[i]); const int Rb = Epi::CMAP ? (64 * (sR[i] >> 5) + perm32(sR[i] & 31)) : (Epi::PERM ? ((sR[i] & ~31) + perm32(sR[i] & 31)) : sR[i]); voffB[i] = (unsigned)(Rb * g.ldb + sC[i]) * 2u; }
    const size_t hstepB = (size_t)(Epi::CMAP ? 32 : 128) * g.ldb * 2;
    const unsigned ldsw = (unsigned)wid * 1024u;
    const int aoff = lds_byte(wr * 64 + fr, fq * 8), boff = lds_byte(wc * 32 + fr, fq * 8);
#define GF_SA(b, h) (((b) * 2 + (h)) * HTB)
#define GF_SB(b, h) ((4 + (b) * 2 + (h)) * HTB)
#define GF_STG(bufoff, base, v0, v1) do { \
        __builtin_amdgcn_global_load_lds((const unsigned*)((base) + (v0)), (LAS unsigned*)(lds + (bufoff) + ldsw), 16, 0, 0); \
        __builtin_amdgcn_global_load_lds((const unsigned*)((base) + (v1)), (LAS unsigned*)(lds + (bufoff) + ldsw + 8192), 16, 0, 0); } while (0)
#define GF_LDA(dst, b, h) do { _Pragma("unroll") for (int m = 0; m < 4; ++m) _Pragma("unroll") for (int k = 0; k < 2; ++k) dst[m][k] = *(const LAS bf16x8*)(lds + GF_SA(b, h) + aoff + m * 2048 + k * 1024); } while (0)
#define GF_LDB(dst, b, h) do { _Pragma("unroll") for (int n = 0; n < 2; ++n) _Pragma("unroll") for (int k = 0; k < 2; ++k) dst[n][k] = *(const LAS bf16x8*)(lds + GF_SB(b, h) + boff + n * 2048 + k * 1024); } while (0)
#define GF_MMA(ai, bj, At, Bt) do { __builtin_amdgcn_s_setprio(1); _Pragma("unroll") for (int m = 0; m < 4; ++m) _Pragma("unroll") for (int n = 0; n < 2; ++n) _Pragma("unroll") for (int k = 0; k < 2; ++k) \
        acc[ai][bj][m][n] = __builtin_amdgcn_mfma_f32_16x16x32_bf16(Bt[n][k], At[m][k], acc[ai][bj][m][n], 0, 0, 0); __builtin_amdgcn_s_setprio(0); } while (0)
#define GF_WAIT_V(n) asm volatile("s_waitcnt vmcnt(" #n ")" ::: "memory")
#define GF_WAIT_L(n) asm volatile("s_waitcnt lgkmcnt(" #n ")" ::: "memory")
#define GF_BAR __builtin_amdgcn_s_barrier()
#define GF_SCHED __builtin_amdgcn_sched_barrier(0)
#define GF_APTR(u, kt) ((const char*)(u).A + (size_t)(kt) * 128)
#define GF_BPTR(u, kt) ((const char*)(((kt) * 64 < g.ksplit) ? (u).B0 + (kt) * 64 : (u).B1 + ((kt) * 64 - g.ksplit)))
#define GF_OFFA(dst, u) do { _Pragma("unroll") for (int h = 0; h < 2; ++h) _Pragma("unroll") for (int i = 0; i < 2; ++i) { const int row_ = h * 128 + sR[i]; \
        const unsigned grow_ = GATHER ? (unsigned)(u).rows[row_] : (unsigned)row_; dst[h][i] = (grow_ * (unsigned)g.lda + (unsigned)sC[i]) * 2u; } } while (0)
    __syncthreads();
    Unit cur, nxt; int ui = 0;
    if (!S.next(0, cur)) return;
    unsigned offA[2][2];
    if (!GATHER) GF_OFFA(offA, cur);
    f32x4 acc[2][2][4][2];
#pragma unroll
    for (int a = 0; a < 2; ++a)
#pragma unroll
        for (int b = 0; b < 2; ++b)
#pragma unroll
            for (int m = 0; m < 4; ++m)
#pragma unroll
                for (int n = 0; n < 2; ++n) acc[a][b][m][n] = (f32x4){0.f, 0.f, 0.f, 0.f};
    bf16x8 At[4][2], B0[2][2], B1[2][2];
    {
        const char* a0 = GF_APTR(cur, 0); const char* b0 = GF_BPTR(cur, 0); const char* a1 = GF_APTR(cur, 1); const char* b1 = GF_BPTR(cur, 1);
        GF_WAIT_L(0);
        GF_STG(GF_SB(0, 0), b0, voffB[0], voffB[1]); GF_STG(GF_SB(0, 1), b0 + hstepB, voffB[0], voffB[1]);
        if (GATHER) { prea(); GF_OFFA(offA, cur); GF_WAIT_L(0); }
        GF_STG(GF_SA(0, 0), a0, offA[0][0], offA[0][1]); GF_STG(GF_SA(0, 1), a0, offA[1][0], offA[1][1]);
        hook();
        if (wr == 1) GF_BAR;
        GF_WAIT_V(2); GF_BAR;
        GF_STG(GF_SB(1, 0), b1, voffB[0], voffB[1]); GF_STG(GF_SA(1, 0), a1, offA[0][0], offA[0][1]); GF_STG(GF_SB(1, 1), b1 + hstepB, voffB[0], voffB[1]);
        GF_WAIT_V(6); GF_BAR;
    }
    for (;;) {
        const bool has_next = S.next(ui + 1, nxt);
#pragma unroll 1
        for (int t = 0; t < nt; t += 2) {
            const bool last = (t == nt - 2), useN = last && has_next;
            const int kt2 = last ? 0 : t + 2;
            const char* a1 = GF_APTR(cur, t + 1);
            const char* a2 = useN ? GF_APTR(nxt, kt2) : GF_APTR(cur, kt2); const char* a3 = a2 + 128;
            const char* b2 = useN ? GF_BPTR(nxt, kt2) : GF_BPTR(cur, kt2);
            const char* b3 = useN ? GF_BPTR(nxt, kt2 + 1) : GF_BPTR(cur, kt2 + 1);
            GF_LDB(B0, 0, 0); GF_LDB(B1, 0, 1); GF_SCHED; GF_LDA(At, 0, 0); GF_STG(GF_SA(1, 1), a1, offA[1][0], offA[1][1]);
            if (GATHER && useN) { GF_OFFA(offA, nxt); }
            GF_WAIT_V(8); GF_WAIT_L(0); GF_BAR; GF_MMA(0, 0, At, B0); GF_MMA(0, 1, At, B1); GF_BAR; GF_SCHED;
            GF_LDA(At, 0, 1); GF_STG(GF_SB(0, 0), b2, voffB[0], voffB[1]); GF_STG(GF_SB(0, 1), b2 + hstepB, voffB[0], voffB[1]); GF_STG(GF_SA(0, 0), a2, offA[0][0], offA[0][1]);
            GF_WAIT_V(8); GF_WAIT_L(0); GF_BAR; GF_MMA(1, 0, At, B0); GF_MMA(1, 1, At, B1); GF_BAR; GF_SCHED;
            GF_LDB(B0, 1, 0); GF_LDB(B1, 1, 1); GF_SCHED; GF_LDA(At, 1, 0); GF_STG(GF_SA(0, 1), a2, offA[1][0], offA[1][1]);
            GF_WAIT_V(8); GF_WAIT_L(0); GF_BAR; GF_MMA(0, 0, At, B0); GF_MMA(0, 1, At, B1); GF_BAR; GF_SCHED;
            GF_LDA(At, 1, 1); GF_STG(GF_SB(1, 0), b3, voffB[0], voffB[1]); GF_STG(GF_SB(1, 1), b3 + hstepB, voffB[0], voffB[1]); GF_STG(GF_SA(1, 0), a3, offA[0][0], offA[0][1]);
            GF_WAIT_V(8); GF_WAIT_L(0); GF_BAR; GF_MMA(1, 0, At, B0); GF_MMA(1, 1, At, B1); GF_BAR; GF_SCHED;
        }
        if (wr == 0) GF_BAR;
        E(acc, cur, wr, wc, fr, fq);
        if (!has_next) break;
#pragma unroll
        for (int a = 0; a < 2; ++a)
#pragma unroll
            for (int b = 0; b < 2; ++b)
#pragma unroll
                for (int m = 0; m < 4; ++m)
#pragma unroll
                    for (int n = 0; n < 2; ++n) acc[a][b][m][n] = (f32x4){0.f, 0.f, 0.f, 0.f};
        cur = nxt; ++ui;
        if (wr == 1) GF_BAR;
    }
    GF_WAIT_V(0);
    GF_BAR;
#undef GF_SA
#undef GF_SB
#undef GF_STG
#undef GF_LDA
#undef GF_LDB
#undef GF_MMA
#undef GF_WAIT_V
#undef GF_WAIT_L
#undef GF_BAR
#undef GF_SCHED
#undef GF_APTR
#undef GF_BPTR
#undef GF_OFFA
}
template <bool GATHER, class Epi, class Sched, class Hook, class PreA>
DEVI void gemm_run(int wv, unsigned char* lds, const GemmShape g, const Sched& S, const Epi& E, const Hook& hook, const PreA& prea) {
#if USE_FAST
    gemm_fast<GATHER>(wv, (LAS unsigned char*)lds + LDS_STAGE, g, S, E, hook, prea);
#else
    prea(); hook(); __syncthreads(); gemm_simple(wv, g, S, E);
#endif
}
template <bool GATHER, class Epi, class Sched, class Hook>
DEVI void gemm_run(int wv, unsigned char* lds, const GemmShape g, const Sched& S, const Epi& E, const Hook& hook) { gemm_run<GATHER>(wv, lds, g, S, E, hook, NoHook{}); }
template <bool GATHER, class Epi, class Sched>
DEVI void gemm_run(int wv, unsigned char* lds, const GemmShape g, const Sched& S, const Epi& E) { gemm_run<GATHER>(wv, lds, g, S, E, NoHook{}); }

DEVI void phase_aproj(const Params& P, int wv, int vc, unsigned char* lds_, int jl, int layer) {
    const int tid = opaque_tid(), lane = tid & 63, wave = tid >> 6, l15 = lane & 15, lq = lane >> 4;
    LAS unsigned char* Wl = (LAS unsigned char*)lds_;
    LAS float* red = (LAS float*)((LAS unsigned char*)lds_ + 33024);
    const bf16_t* hb0 = (const bf16_t*)(P.ws + WS_HB0);
    const bf16_t* wa = (const bf16_t*)(P.ws + WS_GLA_IN) + ((size_t)jl * GLA_IN + GLA_Z) * D;
    const float* ssq = (const float*)(P.ws + WS_SSQP) + (size_t)(layer * 2 + 0) * T * 16;
    float* a = (float*)(P.ws + WS_AGATE);
    const int astep = (int)(gridDim.x >> 3), mt = wave & 3, kh = wave >> 2;
    bf16x8 av[16]; float rsv = 0.f;
    if ((vc >> 3) < 32) {
        const int row = ((vc & 7) * 32 + (vc >> 3)) * 64 + 16 * mt + l15;
        const bf16_t* ap = hb0 + (size_t)row * D + kh * 512 + 8 * lq;
#pragma unroll
        for (int ks = 0; ks < 16; ++ks) av[ks] = *(const bf16x8*)(ap + 32 * ks);
        rsv = rstd16s(ssq, row);
    }
    __syncthreads();
    {
        u32x4 wv4[4];
#pragma unroll
        for (int i = 0; i < 4; ++i) wv4[i] = ((const u32x4*)wa)[tid + NTHREADS * i];
#pragma unroll
        for (int i = 0; i < 4; ++i) { const int q = tid + NTHREADS * i; *(LAS u32x4*)(Wl + (q >> 7) * 2064 + (q & 127) * 16) = wv4[i]; }
    }
    __syncthreads();
    for (int bi_ = vc >> 3; bi_ < 32; bi_ += astep) {
        const int blk = (vc & 7) * 32 + bi_;
        const int row = blk * 64 + 16 * mt + l15;
        f32x4 acc = (f32x4){0.f, 0.f, 0.f, 0.f};
        const LAS unsigned char* bp = Wl + l15 * 2064 + (kh * 512 + 8 * lq) * 2;
        bf16x8 ac[16]; const float rsc = rsv;
#pragma unroll
        for (int ks = 0; ks < 16; ++ks) ac[ks] = av[ks];
        if (bi_ + astep < 32) {
            const int rown = row + astep * 64;
            const bf16_t* ap = hb0 + (size_t)rown * D + kh * 512 + 8 * lq;
#pragma unroll
            for (int ks = 0; ks < 16; ++ks) av[ks] = *(const bf16x8*)(ap + 32 * ks);
            rsv = rstd16s(ssq, rown);
        }
#pragma unroll
        for (int ks = 0; ks < 16; ++ks) acc = __builtin_amdgcn_mfma_f32_16x16x32_bf16(*(const LAS bf16x8*)(bp + 64 * ks), ac[ks], acc, 0, 0, 0);
        __syncthreads();
        if (kh == 1) *(LAS f32x4*)(red + (mt * 64 + lane) * 4) = acc;
        __syncthreads();
        if (kh == 0) {
            const f32x4 o = (acc + *(const LAS f32x4*)(red + (mt * 64 + lane) * 4)) * rsc;
            *(f32x4*)(a + (size_t)row * 16 + 4 * lq) = o;
        }
    }
}
DEVI void phase_g2_simple(const Params& P, int wv, int vc, unsigned char* lds, int jl) {
    const int tid = opaque_tid();
    float* bc = (float*)lds;
    float* ke = (float*)(lds + 32768);
    float* qs = (float*)(lds + 65536);
    float* al = (float*)(lds + 67584);
    float* vl = (float*)(lds + 71680);
    bf16_t* zq = (bf16_t*)(P.ws + WS_ZBUF);
    bf16_t* ST = (bf16_t*)(P.ws + WS_BUF2);
    float* bend = (float*)(P.ws + WS_BEND);
    const float* ag = (const float*)(P.ws + WS_AGATE);
    const float* wgu = P.in[I_GLA_WGU] + (size_t)jl * 16 * 512;
    const float* bg = P.in[I_GLA_BG] + jl * 512;
    for (int ui_ = vc >> 3; ui_ < 128; ui_ += (int)(gridDim.x >> 3)) {
        const int u = (vc & 7) * 128 + ui_;
        const int h = u & 3, n = (u >> 2) & 31, b = u >> 7;
        const int t0 = b * SEQ + n * GCH;
        for (int e = tid; e < 64 * 16; e += NTHREADS) al[e] = ag[(size_t)t0 * 16 + e];
        __syncthreads();
        {
            const int kk = tid & 127, tq = tid >> 7, hk = h * HK + kk;
            float wcol[16];
#pragma unroll
            for (int j = 0; j < 16; ++j) wcol[j] = wgu[j * 512 + hk];
            const float bias = bg[hk];
            float run = 0.f;
            for (int tt = 0; tt < 16; ++tt) {
                const int t = tq * 16 + tt; float x = bias;
#pragma unroll
                for (int j = 0; j < 16; ++j) x += al[t * 16 + j] * wcol[j];
                run += logsigmoidf_(x) * (1.0f / 16.0f);
                bc[t * 128 + kk] = run;
            }
            qs[tq * 128 + kk] = run;
            __syncthreads();
            float pre = 0.f;
            for (int q = 0; q < tq; ++q) pre += qs[q * 128 + kk];
            for (int tt = 0; tt < 16; ++tt) bc[(tq * 16 + tt) * 128 + kk] += pre;
        }
        __syncthreads();
        for (int e = tid; e < 64 * 128; e += NTHREADS) {
            const int t = e >> 7, kk = e & 127;
            const float bcv = bc[t * 128 + kk], be = bc[63 * 128 + kk];
            const size_t qoff = (size_t)(t0 + t) * GLA_Z + h * HK + kk;
            const float qv = bf2f(zq[qoff]), kv = bf2f(zq[qoff + 512]);
            zq[qoff] = (bf16_t)f2bf(qv * 0.08838834764831845f * __expf(bcv));
            zq[qoff + 512] = (bf16_t)f2bf(kv * __expf(-bcv));
            ke[t * 128 + kk] = bf2f(f2bf(kv * __expf(be - bcv)));
        }
        for (int e = tid; e < 64 * 256; e += NTHREADS) { const int t = e >> 8, vv = e & 255; vl[e] = bf2f(zq[(size_t)(t0 + t) * GLA_Z + 1024 + h * HV + vv]); }
        if (tid < 128) bend[u * 128 + tid] = bc[63 * 128 + tid];
        __syncthreads();
        {
            const int kk = tid & 127, vg = tid >> 7;
            float kcol[64];
#pragma unroll
            for (int t = 0; t < 64; ++t) kcol[t] = ke[t * 128 + kk];
            for (int vi = 0; vi < 64; ++vi) {
                const int vv = vg * 64 + vi; float s = 0.f;
#pragma unroll
                for (int t = 0; t < 64; ++t) s += kcol[t] * vl[t * 256 + vv];
                ST[(size_t)u * 32768 + vv * 128 + kk] = (bf16_t)f2bf(s);
            }
        }
        __syncthreads();
    }
}
DEVI void phase_g3(const Params& P, int wv, int vc, unsigned char* lds_) {
    const int tid = opaque_tid();
    LAS float* dec = (LAS float*)((LAS unsigned char*)lds_);
    unsigned char* ST = P.ws + WS_BUF2;
    const float* bend = (const float*)(P.ws + WS_BEND);
    for (int wi_ = vc >> 3; wi_ < 32; wi_ += (int)(gridDim.x >> 3)) {
        const int wg = (vc & 7) * 32 + wi_;
        const int vg = wg & 7, h = (wg >> 3) & 3, b = wg >> 5;
        int tl = tid; asm volatile("" : "+v"(tl));
        const int kc = tl & 15, vv = vg * 32 + (tl >> 4);
        __syncthreads();
        u32x2 kv[32];
        unsigned char* base = ST + (size_t)(b * 128 + h) * 32768 + vv * 128 + kc * 8;
#pragma unroll
        for (int n = 0; n < 32; ++n) kv[n] = *(const u32x2*)(base + (size_t)n * 4 * 32768);
#pragma unroll
        for (int i = 0; i < 8; ++i) { const int e = tl + NTHREADS * i; const int n = e >> 7, kk = e & 127; dec[e] = __expf(bend[((b * 32 + n) * 4 + h) * 128 + kk]); }
        __syncthreads();
        float st[8]; float zero = 0.f; asm volatile("" : "+v"(zero));
#pragma unroll
        for (int j = 0; j < 8; ++j) st[j] = zero;
#pragma unroll
        for (int n = 0; n < 32; ++n) {
            u32x2 o; o.x = pk4_fp8(st[0], st[1], st[2], st[3]); o.y = pk4_fp8(st[4], st[5], st[6], st[7]);
            *(u32x2*)(base + (size_t)n * 4 * 32768) = o;
            const f32x4 d0 = *(const LAS f32x4*)(dec + n * 128 + kc * 8), d1 = *(const LAS f32x4*)(dec + n * 128 + kc * 8 + 4);
            const f32x2 k01 = fp8lo2(kv[n].x), k23 = fp8hi2(kv[n].x), k45 = fp8lo2(kv[n].y), k67 = fp8hi2(kv[n].y);
            st[0] = d0.x * st[0] + k01.x; st[1] = d0.y * st[1] + k01.y;
            st[2] = d0.z * st[2] + k23.x; st[3] = d0.w * st[3] + k23.y;
            st[4] = d1.x * st[4] + k45.x; st[5] = d1.y * st[5] + k45.y;
            st[6] = d1.z * st[6] + k67.x; st[7] = d1.w * st[7] + k67.y;
        }
    }
}
DEVI void phase_g4_simple(const Params& P, int wv, int vc, unsigned char* lds, int jl) {
    const int tid = opaque_tid(), lane = tid & 63, wave = tid >> 6;
    float* qd = (float*)lds;
    float* kd = (float*)(lds + 33024);
    float* Pm = (float*)(lds + 66048);
    float* O = (float*)(lds + 82688);
    const bf16_t* zq = (const bf16_t*)(P.ws + WS_ZBUF);
    bf16_t* ob = (bf16_t*)(P.ws + WS_ZBUF + ZB_OB);
    const bf16_t* ST = (const bf16_t*)(P.ws + WS_BUF2);
    const float* gh = P.in[I_GLA_GH] + jl * 1024;
    for (int ui_ = vc >> 3; ui_ < 128; ui_ += (int)(gridDim.x >> 3)) {
        const int u = (vc & 7) * 128 + ui_;
        const int h = u & 3, n = (u >> 2) & 31, b = u >> 7;
        const int t0 = b * SEQ + n * GCH;
        for (int e = tid; e < 64 * 128; e += NTHREADS) {
            const int t = e >> 7, kk = e & 127; const size_t qoff = (size_t)(t0 + t) * GLA_Z + h * HK + kk;
            qd[t * 129 + kk] = bf2f(zq[qoff]); kd[t * 129 + kk] = bf2f(zq[qoff + 512]);
        }
        __syncthreads();
        for (int e = tid; e < 64 * 64; e += NTHREADS) {
            const int i = e >> 6, j = e & 63; float s = 0.f;
            if (j <= i) { for (int kk = 0; kk < 128; ++kk) s += qd[i * 129 + kk] * kd[j * 129 + kk]; }
            Pm[i * 65 + j] = s;
        }
        __syncthreads();
        {
            const int vv = tid & 255, ih = tid >> 8;
#pragma unroll 1
            for (int hf = 0; hf < 2; ++hf) {
                float S[64];
                const u32x4* sp = (const u32x4*)(ST + (size_t)u * 32768 + vv * 128 + hf * 64);
#pragma unroll
                for (int c = 0; c < 8; ++c) { const u32x4 w = sp[c]; S[8 * c + 0] = bflo(w.x); S[8 * c + 1] = bfhi(w.x); S[8 * c + 2] = bflo(w.y); S[8 * c + 3] = bfhi(w.y); S[8 * c + 4] = bflo(w.z); S[8 * c + 5] = bfhi(w.z); S[8 * c + 6] = bflo(w.w); S[8 * c + 7] = bfhi(w.w); }
#pragma unroll 1
                for (int ii = 0; ii < 32; ++ii) {
                    const int i = ih * 32 + ii; float o = hf ? O[i * 256 + vv] : 0.f;
#pragma unroll
                    for (int kk = 0; kk < 64; ++kk) o += qd[i * 129 + hf * 64 + kk] * S[kk];
                    O[i * 256 + vv] = o;
                }
            }
            {
                float V[64];
#pragma unroll
                for (int j = 0; j < 64; ++j) V[j] = bf2f(zq[(size_t)(t0 + j) * GLA_Z + 1024 + h * HV + vv]);
                for (int ii = 0; ii < 32; ++ii) {
                    const int i = ih * 32 + ii; float o = O[i * 256 + vv];
#pragma unroll
                    for (int j = 0; j < 64; ++j) o += Pm[i * 65 + j] * V[j];
                    O[i * 256 + vv] = o;
                }
            }
        }
        __syncthreads();
        for (int ii = 0; ii < 8; ++ii) {
            const int i = wave * 8 + ii;
            float x[4]; float s = 0.f;
#pragma unroll
            for (int q = 0; q < 4; ++q) { x[q] = O[i * 256 + lane + 64 * q]; s += x[q] * x[q]; }
            s = wave_sum(s);
            const float rs = rsqrtf(s * (1.0f / HV) + EPS);
#pragma unroll
            for (int q = 0; q < 4; ++q) {
                const int vv = lane + 64 * q;
                const float r = bf2f(zq[(size_t)(t0 + i) * GLA_Z + 2048 + h * HV + vv]);
                ob[(size_t)(t0 + i) * 1024 + h * HV + vv] = (bf16_t)f2bf(x[q] * rs * gh[h * HV + vv] * siluf_(r));
            }
        }
        __syncthreads();
    }
}

DEVI void phase_s2_simple(const Params& P, int wv, int vc, unsigned char* lds, int jl) {
    const int tid = opaque_tid();
    float* w = (float*)lds;
    float* mu = (float*)(lds + 65536);
    float* rsd = (float*)(lds + 65536 + 512);
    const bf16_t* z = (const bf16_t*)(P.ws + WS_ZBUF);
    bf16_t* ug = (bf16_t*)(P.ws + WS_BUF2);
    const float* lnstat = (const float*)(P.ws + WS_LNP) + (size_t)jl * T * 64;
    const bf16_t* wsb = (const bf16_t*)(P.ws + WS_SGUWS) + (size_t)jl * 8 * 128 * 128;
    const float* lng = P.in[I_SGU_LNG] + jl * SGU_W; const float* lnb = P.in[I_SGU_LNB] + jl * SGU_W;
    const float* bs = P.in[I_SGU_BS] + jl * 8 * 128;
    for (int ui_ = vc >> 3; ui_ < 128; ui_ += (int)(gridDim.x >> 3)) {
        const int u = (vc & 7) * 128 + ui_;
        const int g = u & 7, n = (u >> 3) & 15, b = u >> 7;
        const int t0 = b * SEQ + n * SCH;
        for (int e = tid; e < 128 * 128; e += NTHREADS) w[e] = bf2f(wsb[(size_t)g * 16384 + e]);
        if (tid < 128) {
            float s1 = 0.f, s2 = 0.f; f32x4 sv[16];
#pragma unroll
            for (int q = 0; q < 16; ++q) sv[q] = *(const f32x4*)(lnstat + (size_t)(t0 + tid) * 64 + 4 * q);
#pragma unroll
            for (int q = 0; q < 16; ++q) { s1 += sv[q].x; s2 += sv[q].y; s1 += sv[q].z; s2 += sv[q].w; }
            const float mean = s1 * (1.0f / SGU_W); const float var = fmaxf(s2 * (1.0f / SGU_W) - mean * mean, 0.f);
            mu[tid] = mean; rsd[tid] = rsqrtf(var + EPS);
        }
        __syncthreads();
        {
            const int c = tid & 255, th = tid >> 8, col = g * SGC + c;
            const float gg = lng[col], bb = lnb[col];
            float vn[128];
#pragma unroll
            for (int s = 0; s < 128; ++s) { const float x = bf2f(z[(size_t)(t0 + s) * SGU_Z + SGU_W + col]); vn[s] = (x - mu[s]) * rsd[s] * gg + bb; }
            for (int tt = 0; tt < 64; ++tt) {
                const int t = 2 * tt + th; float s = bs[g * 128 + t];
#pragma unroll
                for (int sp = 0; sp < 128; ++sp) s += w[t * 128 + sp] * vn[sp];
                const float uv = bf2f(z[(size_t)(t0 + t) * SGU_Z + col]);
                ug[(size_t)(t0 + t) * SGU_W + col] = (bf16_t)f2bf(uv * s);
            }
        }
        __syncthreads();
    }
}


typedef short v4i16_t __attribute__((ext_vector_type(4)));
DEVI bf16x8 lds_col8(const LAS unsigned short* p, int ld, int l15) {
    const LAS unsigned short* a = p + ((l15 >> 2) * ld + 4 * (l15 & 3) - l15);
    const v4i16_t lo = __builtin_amdgcn_ds_read_tr16_b64_v4i16((LAS v4i16_t*)a), hi = __builtin_amdgcn_ds_read_tr16_b64_v4i16((LAS v4i16_t*)(a + 4 * ld));
    bf16x8 r; r[0] = lo[0]; r[1] = lo[1]; r[2] = lo[2]; r[3] = lo[3]; r[4] = hi[0]; r[5] = hi[1]; r[6] = hi[2]; r[7] = hi[3];
    return r;
}
DEVI f32x4 mfma16(bf16x8 a, bf16x8 b, f32x4 c) { return __builtin_amdgcn_mfma_f32_16x16x32_bf16(a, b, c, 0, 0, 0); }

struct G2Pre { float al[2]; u32x4 vw[4], qw[2], kw[2]; };
DEVI void g2_load(G2Pre& p, const bf16_t* zq, const float* ag, int u, int tid) {
    const int h = u & 3, n = (u >> 2) & 31, b = u >> 7, t0 = b * SEQ + n * GCH;
#pragma unroll
    for (int i = 0; i < 2; ++i) p.al[i] = ag[(size_t)t0 * 16 + tid + NTHREADS * i];
#pragma unroll
    for (int i = 0; i < 4; ++i) {
        const int c = tid + NTHREADS * i, row = c >> 5, cc = c & 31;
        p.vw[i] = *(const u32x4*)(zq + (size_t)(t0 + row) * GLA_Z + 1024 + h * HV + 8 * cc);
    }
#pragma unroll
    for (int i = 0; i < 2; ++i) {
        const int c = tid + NTHREADS * i, t = c >> 4, cc = c & 15;
        const size_t qoff = (size_t)(t0 + t) * GLA_Z + h * HK + 8 * cc;
        p.qw[i] = *(const u32x4*)(zq + qoff); p.kw[i] = *(const u32x4*)(zq + qoff + 512);
    }
}
template <bool HAS_NEXT>
DEVI void g2_unit(G2Pre& nx, bf16_t* zq, unsigned char* ST, float* bend, const float* ag, const float (&wcol)[16], float bias, LAS unsigned char* lds, int u, int u_next,
                  int tid, int wave, int l15, int lq) {
    LAS float* bc = (LAS float*)lds;
    LAS float* al = (LAS float*)(lds + 33024);
    LAS float* qs = (LAS float*)(lds + 37120);
    LAS unsigned short* Ke = (LAS unsigned short*)(lds + 39168);
    LAS unsigned short* V = (LAS unsigned short*)(lds + 56064);
    const int h = u & 3, n = (u >> 2) & 31, b = u >> 7;
    const int t0 = b * SEQ + n * GCH;
    __syncthreads();
#pragma unroll
    for (int i = 0; i < 2; ++i) al[tid + NTHREADS * i] = nx.al[i];
#pragma unroll
    for (int i = 0; i < 4; ++i) {
        const int c = tid + NTHREADS * i, row = c >> 5, cc = c & 31;
        const u32x4 w = nx.vw[i];
        *(LAS u32x2*)(V + row * 260 + cc * 8) = (u32x2){w.x, w.y}; *(LAS u32x2*)(V + row * 260 + cc * 8 + 4) = (u32x2){w.z, w.w};
    }
    const u32x4 qwc[2] = {nx.qw[0], nx.qw[1]}, kwc[2] = {nx.kw[0], nx.kw[1]};
    if (HAS_NEXT) g2_load(nx, zq, ag, u_next, tid);
    __syncthreads();
    {
        const int kk = tid & 127, tq = tid >> 7;
        float run = 0.f;
        for (int tt = 0; tt < 16; ++tt) {
            const int t = tq * 16 + tt; float x = bias;
#pragma unroll
            for (int j = 0; j < 16; ++j) x += al[t * 16 + j] * wcol[j];
            run += logsigmoidf_(x) * (1.0f / 16.0f);
            bc[t * 129 + kk] = run;
        }
        qs[tq * 128 + kk] = run;
        __syncthreads();
        float pre = 0.f;
        for (int q = 0; q < tq; ++q) pre += qs[q * 128 + kk];
        for (int tt = 0; tt < 16; ++tt) bc[(tq * 16 + tt) * 129 + kk] += pre;
    }
    __syncthreads();
#pragma unroll
    for (int i = 0; i < 2; ++i) {
        const int c = tid + NTHREADS * i, t = c >> 4, cc = c & 15;
        const size_t qoff = (size_t)(t0 + t) * GLA_Z + h * HK + 8 * cc;
        const u32x4 qw = qwc[i], kw = kwc[i];
        const unsigned qa[4] = {qw.x, qw.y, qw.z, qw.w}, ka[4] = {kw.x, kw.y, kw.z, kw.w};
        unsigned qo[4], ko[4], eo[4];
#pragma unroll
        for (int j = 0; j < 4; ++j) {
            const float b0 = bc[t * 129 + 8 * cc + 2 * j], b1 = bc[t * 129 + 8 * cc + 2 * j + 1];
            const float e0 = bc[63 * 129 + 8 * cc + 2 * j], e1 = bc[63 * 129 + 8 * cc + 2 * j + 1];
            const float q0 = bflo(qa[j]), q1 = bfhi(qa[j]), k0 = bflo(ka[j]), k1 = bfhi(ka[j]);
            qo[j] = cvt_pk_bf16(q0 * 0.08838834764831845f * __expf(b0), q1 * 0.08838834764831845f * __expf(b1));
            ko[j] = cvt_pk_bf16(k0 * __expf(-b0), k1 * __expf(-b1));
            eo[j] = cvt_pk_bf16(k0 * __expf(e0 - b0), k1 * __expf(e1 - b1));
        }
        *(u32x4*)(zq + qoff) = (u32x4){qo[0], qo[1], qo[2], qo[3]};
        *(u32x4*)(zq + qoff + 512) = (u32x4){ko[0], ko[1], ko[2], ko[3]};
        *(LAS u32x2*)(Ke + t * 132 + cc * 8) = (u32x2){eo[0], eo[1]}; *(LAS u32x2*)(Ke + t * 132 + cc * 8 + 4) = (u32x2){eo[2], eo[3]};
    }
    if (tid < 128) bend[u * 128 + tid] = bc[63 * 129 + tid];
    __syncthreads();
    {
        bf16x8 Av[2][2];
#pragma unroll
        for (int vt = 0; vt < 2; ++vt)
#pragma unroll
            for (int ks = 0; ks < 2; ++ks) Av[vt][ks] = lds_col8(V + (32 * ks + 8 * lq) * 260 + 16 * (2 * wave + vt) + l15, 260, l15);
#pragma unroll 2
        for (int kt = 0; kt < 8; ++kt) {
            bf16x8 Bk[2];
#pragma unroll
            for (int ks = 0; ks < 2; ++ks) Bk[ks] = lds_col8(Ke + (32 * ks + 8 * lq) * 132 + 16 * kt + l15, 132, l15);
#pragma unroll
            for (int vt = 0; vt < 2; ++vt) {
                f32x4 acc = (f32x4){0.f, 0.f, 0.f, 0.f};
                acc = mfma16(Bk[0], Av[vt][0], acc); acc = mfma16(Bk[1], Av[vt][1], acc);
                *(unsigned*)(ST + (size_t)u * 32768 + (16 * (2 * wave + vt) + l15) * 128 + 16 * kt + 4 * lq) = pk4_fp8(acc.x, acc.y, acc.z, acc.w);
            }
        }
    }
}
DEVI void phase_g2_fast(const Params& P, int wv, int vc, unsigned char* lds_, int jl) {
    const int tid = opaque_tid(), lane = tid & 63, wave = tid >> 6, l15 = lane & 15, lq = lane >> 4;
    LAS unsigned char* lds = (LAS unsigned char*)lds_;
    bf16_t* zq = (bf16_t*)(P.ws + WS_ZBUF);
    unsigned char* ST = P.ws + WS_BUF2;
    float* bend = (float*)(P.ws + WS_BEND);
    const float* ag = (const float*)(P.ws + WS_AGATE);
    const float* wgu = P.in[I_GLA_WGU] + (size_t)jl * 16 * 512;
    const float* bg = P.in[I_GLA_BG] + jl * 512;
    const int step = (int)(gridDim.x >> 3), ubase = (vc & 7) * 128;
    int ui_ = vc >> 3;
    if (ui_ >= 128) return;
    G2Pre nx;
    g2_load(nx, zq, ag, ubase + ui_, tid);
    for (;;) {
        const int u = ubase + ui_, hk = (u & 3) * HK + (tid & 127);
        float wcol[16];
#pragma unroll
        for (int j = 0; j < 16; ++j) wcol[j] = wgu[j * 512 + hk];
        const float bias = bg[hk];
        if (ui_ + step < 128) { g2_unit<true>(nx, zq, ST, bend, ag, wcol, bias, lds, u, u + step, tid, wave, l15, lq); ui_ += step; }
        else { g2_unit<false>(nx, zq, ST, bend, ag, wcol, bias, lds, u, u, tid, wave, l15, lq); break; }
    }
}

struct G4Pre { u32x2 Bs8[2][4]; u32x2 rr[4][2]; u32x4 qw[2], kw[2], vw[4]; };
DEVI void g4_load(G4Pre& p, const bf16_t* zq, const unsigned char* ST, int u, int tid, int wave, int l15, int lq) {
    const int h = u & 3, n = (u >> 2) & 31, b = u >> 7, t0 = b * SEQ + n * GCH;
#pragma unroll
    for (int nt = 0; nt < 2; ++nt)
#pragma unroll
        for (int ks = 0; ks < 4; ++ks) p.Bs8[nt][ks] = *(const u32x2*)(ST + (size_t)u * 32768 + (16 * (2 * wave + nt) + l15) * 128 + 32 * ks + 8 * lq);
#pragma unroll
    for (int mt = 0; mt < 4; ++mt)
#pragma unroll
        for (int nt = 0; nt < 2; ++nt) p.rr[mt][nt] = *(const u32x2*)(zq + (size_t)(t0 + 16 * mt + l15) * GLA_Z + 2048 + h * HV + 16 * (2 * wave + nt) + 4 * lq);
#pragma unroll
    for (int i = 0; i < 2; ++i) {
        const int c = tid + NTHREADS * i, row = c >> 4, cc = c & 15;
        const size_t qoff = (size_t)(t0 + row) * GLA_Z + h * HK + 8 * cc;
        p.qw[i] = *(const u32x4*)(zq + qoff); p.kw[i] = *(const u32x4*)(zq + qoff + 512);
    }
#pragma unroll
    for (int i = 0; i < 4; ++i) {
        const int c = tid + NTHREADS * i, row = c >> 5, cc = c & 31;
        p.vw[i] = *(const u32x4*)(zq + (size_t)(t0 + row) * GLA_Z + 1024 + h * HV + 8 * cc);
    }
}
template <bool HAS_NEXT>
DEVI void g4_unit(G4Pre& nx, const bf16_t* zq, bf16_t* ob, const unsigned char* ST, const f32x4 (&g4)[2], LAS unsigned char* lds, int u, int u_next, int tid, int wave, int l15, int lq) {
    LAS unsigned char* Q = lds;
    LAS unsigned char* Kd = lds + 17408;
    LAS unsigned short* V = (LAS unsigned short*)(lds + 34816);
    LAS unsigned short* Pm = (LAS unsigned short*)(lds + 68096);
    LAS float* part = (LAS float*)(lds + 77312);
    const int h = u & 3, n = (u >> 2) & 31, b = u >> 7;
    const int t0 = b * SEQ + n * GCH;
    __syncthreads();
    bf16x8 Bs[2][4]; u32x2 rr[4][2];
#pragma unroll
    for (int mt = 0; mt < 4; ++mt)
#pragma unroll
        for (int nt = 0; nt < 2; ++nt) rr[mt][nt] = nx.rr[mt][nt];
#pragma unroll
    for (int i = 0; i < 2; ++i) {
        const int c = tid + NTHREADS * i, row = c >> 4, cc = c & 15;
        *(LAS u32x4*)(Q + row * 272 + cc * 16) = nx.qw[i]; *(LAS u32x4*)(Kd + row * 272 + cc * 16) = nx.kw[i];
    }
#pragma unroll
    for (int i = 0; i < 4; ++i) {
        const int c = tid + NTHREADS * i, row = c >> 5, cc = c & 31;
        const u32x4 w = nx.vw[i];
        *(LAS u32x2*)(V + row * 260 + cc * 8) = (u32x2){w.x, w.y}; *(LAS u32x2*)(V + row * 260 + cc * 8 + 4) = (u32x2){w.z, w.w};
    }
#pragma unroll
    for (int nt = 0; nt < 2; ++nt)
#pragma unroll
        for (int ks = 0; ks < 4; ++ks) {
            const f32x2 s01 = fp8lo2(nx.Bs8[nt][ks].x), s23 = fp8hi2(nx.Bs8[nt][ks].x), s45 = fp8lo2(nx.Bs8[nt][ks].y), s67 = fp8hi2(nx.Bs8[nt][ks].y);
            const u32x4 w = (u32x4){cvt_pk_bf16(s01.x, s01.y), cvt_pk_bf16(s23.x, s23.y), cvt_pk_bf16(s45.x, s45.y), cvt_pk_bf16(s67.x, s67.y)};
            Bs[nt][ks] = __builtin_bit_cast(bf16x8, w);
        }
    if (HAS_NEXT) g4_load(nx, zq, ST, u_next, tid, wave, l15, lq);
    __syncthreads();
    for (int tile = wave; tile < 12; tile += 8) {
        if (tile >= 10) {
            const int ti = tile == 10 ? 0 : 2, tj = ti + 1;
#pragma unroll
            for (int r = 0; r < 4; ++r) Pm[(16 * ti + 4 * lq + r) * 72 + 16 * tj + l15] = 0;
        } else {
            const int ti = tile >= 6 ? 3 : (tile >= 3 ? 2 : (tile >= 1 ? 1 : 0)), tj = tile - (ti * (ti + 1)) / 2;
            f32x4 acc = (f32x4){0.f, 0.f, 0.f, 0.f};
#pragma unroll
            for (int ks = 0; ks < 4; ++ks) {
                const bf16x8 a = *(const LAS bf16x8*)(Q + (16 * ti + l15) * 272 + (32 * ks + 8 * lq) * 2);
                const bf16x8 bb = *(const LAS bf16x8*)(Kd + (16 * tj + l15) * 272 + (32 * ks + 8 * lq) * 2);
                acc = mfma16(a, bb, acc);
            }
#pragma unroll
            for (int r = 0; r < 4; ++r) {
                const int i = 16 * ti + 4 * lq + r, j = 16 * tj + l15;
                Pm[i * 72 + j] = (unsigned short)f2bf(j <= i ? acc[r] : 0.f);
            }
        }
    }
    __syncthreads();
    f32x4 acc[4][2];
    {
        bf16x8 Bv[2][2];
#pragma unroll
        for (int nt = 0; nt < 2; ++nt)
#pragma unroll
            for (int ks = 0; ks < 2; ++ks) Bv[nt][ks] = lds_col8(V + (32 * ks + 8 * lq) * 260 + 16 * (2 * wave + nt) + l15, 260, l15);
#pragma unroll
        for (int mt = 0; mt < 4; ++mt) {
            acc[mt][0] = (f32x4){0.f, 0.f, 0.f, 0.f}; acc[mt][1] = (f32x4){0.f, 0.f, 0.f, 0.f};
#pragma unroll
            for (int ks = 0; ks < 2; ++ks) if (ks <= ((16 * mt + 15) >> 5)) {
                const bf16x8 ap = *(const LAS bf16x8*)((const LAS unsigned char*)Pm + (16 * mt + l15) * 144 + (32 * ks + 8 * lq) * 2);
                acc[mt][0] = mfma16(Bv[0][ks], ap, acc[mt][0]); acc[mt][1] = mfma16(Bv[1][ks], ap, acc[mt][1]);
            }
#pragma unroll
            for (int ks = 0; ks < 4; ++ks) {
                const bf16x8 aq = *(const LAS bf16x8*)(Q + (16 * mt + l15) * 272 + (32 * ks + 8 * lq) * 2);
                acc[mt][0] = mfma16(Bs[0][ks], aq, acc[mt][0]); acc[mt][1] = mfma16(Bs[1][ks], aq, acc[mt][1]);
            }
        }
    }
#pragma unroll
    for (int mt = 0; mt < 4; ++mt) {
        float s2 = 0.f;
#pragma unroll
        for (int nt = 0; nt < 2; ++nt) s2 += acc[mt][nt].x * acc[mt][nt].x + acc[mt][nt].y * acc[mt][nt].y + acc[mt][nt].z * acc[mt][nt].z + acc[mt][nt].w * acc[mt][nt].w;
        s2 += __shfl_xor(s2, 16); s2 += __shfl_xor(s2, 32);
        if (lq == 0) part[wave * 64 + 16 * mt + l15] = s2;
    }
    __syncthreads();
#pragma unroll
    for (int mt = 0; mt < 4; ++mt) {
        const int i = 16 * mt + l15; float tot = 0.f;
#pragma unroll
        for (int w8 = 0; w8 < 8; ++w8) tot += part[w8 * 64 + i];
        const float rs = rsqrtf(tot * (1.0f / HV) + EPS);
#pragma unroll
        for (int nt = 0; nt < 2; ++nt) {
            const int vv = 16 * (2 * wave + nt) + 4 * lq;
            const float r0 = bflo(rr[mt][nt].x), r1 = bfhi(rr[mt][nt].x), r2 = bflo(rr[mt][nt].y), r3 = bfhi(rr[mt][nt].y);
            const f32x4 a = acc[mt][nt];
            u32x2 o; o.x = cvt_pk_bf16(a.x * rs * g4[nt].x * siluf_(r0), a.y * rs * g4[nt].y * siluf_(r1)); o.y = cvt_pk_bf16(a.z * rs * g4[nt].z * siluf_(r2), a.w * rs * g4[nt].w * siluf_(r3));
            *(u32x2*)(ob + (size_t)(t0 + i) * 1024 + h * HV + vv) = o;
        }
    }
}
DEVI void phase_g4_fast(const Params& P, int wv, int vc, unsigned char* lds_, int jl) {
    const int tid = opaque_tid(), lane = tid & 63, wave = tid >> 6, l15 = lane & 15, lq = lane >> 4;
    LAS unsigned char* lds = (LAS unsigned char*)lds_;
    const bf16_t* zq = (const bf16_t*)(P.ws + WS_ZBUF);
    bf16_t* ob = (bf16_t*)(P.ws + WS_ZBUF + ZB_OB);
    const unsigned char* ST = P.ws + WS_BUF2;
    const float* gh = P.in[I_GLA_GH] + jl * 1024;
    const int step = (int)(gridDim.x >> 3), ubase = (vc & 7) * 128;
    int ui_ = vc >> 3;
    if (ui_ >= 128) return;
    f32x4 g4[2];
    G4Pre nx;
    g4_load(nx, zq, ST, ubase + ui_, tid, wave, l15, lq);
    for (;;) {
        const int u = ubase + ui_, h = u & 3;
#pragma unroll
        for (int nt = 0; nt < 2; ++nt) g4[nt] = *(const f32x4*)(gh + h * HV + 16 * (2 * wave + nt) + 4 * lq);
        if (ui_ + step < 128) { g4_unit<true>(nx, zq, ob, ST, g4, lds, u, u + step, tid, wave, l15, lq); ui_ += step; }
        else { g4_unit<false>(nx, zq, ob, ST, g4, lds, u, u, tid, wave, l15, lq); break; }
    }
}

struct S2Pre { f32x4 sv[4]; u32x4 vw[4]; unsigned uu[8][2]; };
DEVI void s2_load(S2Pre& p, const unsigned char* z, const float* lnstat, int u, int tid, int wave, int l15, int lq) {
    const int g = u & 7, n = (u >> 3) & 15, b = u >> 7, t0 = b * SEQ + n * SCH;
#pragma unroll
    for (int q = 0; q < 4; ++q) p.sv[q] = *(const f32x4*)(lnstat + (size_t)(t0 + (tid >> 2)) * 64 + 16 * (tid & 3) + 4 * q);
    const int col = g * SGC + (tid & 15) * 16;
#pragma unroll
    for (int i = 0; i < 4; ++i) p.vw[i] = *(const u32x4*)(z + (size_t)(t0 + (tid >> 4) + 32 * i) * SGU_Z + SGU_W + col);
#pragma unroll
    for (int tt = 0; tt < 8; ++tt)
#pragma unroll
        for (int ct = 0; ct < 2; ++ct) p.uu[tt][ct] = *(const unsigned*)(z + (size_t)(t0 + 16 * tt + l15) * SGU_Z + g * SGC + 16 * (2 * wave + ct) + 4 * lq);
}
template <bool HAS_NEXT>
DEVI void s2_unit(S2Pre& nx, const unsigned char* z, bf16_t* ug, const float* lnstat, const float (&gg)[16], const float (&bb)[16], const float (&bias8)[8], LAS unsigned char* lds, int u, int u_next,
                  int tid, int wave, int l15, int lq) {
    LAS unsigned short* X = (LAS unsigned short*)lds;
    LAS unsigned char* Wl = lds + 66560;
    LAS float* mu = (LAS float*)(lds + 101376); LAS float* rsd = mu + 128;
    const int g = u & 7, n = (u >> 3) & 15, b = u >> 7;
    const int t0 = b * SEQ + n * SCH;
    {
        float s1 = 0.f, s2 = 0.f;
#pragma unroll
        for (int q = 0; q < 4; ++q) { s1 += nx.sv[q].x; s2 += nx.sv[q].y; s1 += nx.sv[q].z; s2 += nx.sv[q].w; }
        s1 += __shfl_xor(s1, 1); s2 += __shfl_xor(s2, 1); s1 += __shfl_xor(s1, 2); s2 += __shfl_xor(s2, 2);
        const float mean = s1 * (1.0f / SGU_W); const float var = fmaxf(s2 * (1.0f / SGU_W) - mean * mean, 0.f);
        if ((tid & 3) == 0) { mu[tid >> 2] = mean; rsd[tid >> 2] = rsqrtf(var + EPS); }
    }
    u32x4 vw[4]; unsigned uu[8][2];
#pragma unroll
    for (int i = 0; i < 4; ++i) vw[i] = nx.vw[i];
#pragma unroll
    for (int tt = 0; tt < 8; ++tt) { uu[tt][0] = nx.uu[tt][0]; uu[tt][1] = nx.uu[tt][1]; }
    if (HAS_NEXT) s2_load(nx, z, lnstat, u_next, tid, wave, l15, lq);
    __syncthreads();
    {
        const int cc = tid & 15;
#pragma unroll
        for (int i = 0; i < 4; ++i) {
            const int s = (tid >> 4) + 32 * i;
            const u32x4 w = vw[i];
            const float m = mu[s], r = rsd[s];
            const unsigned wa[4] = {w.x, w.y, w.z, w.w}; unsigned o[8];
#pragma unroll
            for (int j = 0; j < 4; ++j) {
                const f32x2 a = fp8lo2(wa[j]), c = fp8hi2(wa[j]);
                o[2 * j] = cvt_pk_bf16((a.x - m) * r * gg[4 * j] + bb[4 * j], (a.y - m) * r * gg[4 * j + 1] + bb[4 * j + 1]);
                o[2 * j + 1] = cvt_pk_bf16((c.x - m) * r * gg[4 * j + 2] + bb[4 * j + 2], (c.y - m) * r * gg[4 * j + 3] + bb[4 * j + 3]);
            }
#pragma unroll
            for (int j = 0; j < 4; ++j) *(LAS u32x2*)(X + s * 260 + cc * 16 + 4 * j) = (u32x2){o[2 * j], o[2 * j + 1]};
        }
    }
    __syncthreads();
    {
        bf16x8 Bf[2][4];
#pragma unroll
        for (int ct = 0; ct < 2; ++ct)
#pragma unroll
            for (int ks = 0; ks < 4; ++ks) Bf[ct][ks] = lds_col8(X + (32 * ks + 8 * lq) * 260 + 16 * (2 * wave + ct) + l15, 260, l15);
#pragma unroll
        for (int tt = 0; tt < 8; ++tt) {
            f32x4 acc0 = (f32x4){0.f, 0.f, 0.f, 0.f}, acc1 = (f32x4){0.f, 0.f, 0.f, 0.f};
#pragma unroll
            for (int ks = 0; ks < 4; ++ks) if (ks <= ((16 * tt + 15) >> 5)) {
                const bf16x8 af = *(const LAS bf16x8*)(Wl + (16 * tt + l15) * 272 + (32 * ks + 8 * lq) * 2);
                acc0 = mfma16(Bf[0][ks], af, acc0); acc1 = mfma16(Bf[1][ks], af, acc1);
            }
            const int t = 16 * tt + l15; const float bias = bias8[tt];
#pragma unroll
            for (int ct = 0; ct < 2; ++ct) {
                const f32x4 a = ct ? acc1 : acc0; const unsigned uw = uu[tt][ct];
                const f32x2 u01 = gelu_tanh2(fp8lo2(uw)), u23 = gelu_tanh2(fp8hi2(uw));
                u32x2 o; o.x = cvt_pk_bf16(u01.x * (a.x + bias), u01.y * (a.y + bias)); o.y = cvt_pk_bf16(u23.x * (a.z + bias), u23.y * (a.w + bias));
                *(u32x2*)(ug + (size_t)(t0 + t) * SGU_W + g * SGC + 16 * (2 * wave + ct) + 4 * lq) = o;
            }
        }
    }
}
DEVI void phase_s2_fast(const Params& P, int wv, int vc, unsigned char* lds_, int jl) {
    const int tid = opaque_tid(), lane = tid & 63, wave = tid >> 6, l15 = lane & 15, lq = lane >> 4;
    LAS unsigned char* lds = (LAS unsigned char*)lds_;
    LAS unsigned char* Wl = lds + 66560;
    const unsigned char* z = P.ws + WS_ZBUF;
    bf16_t* ug = (bf16_t*)(P.ws + WS_BUF2);
    const float* lnstat = (const float*)(P.ws + WS_LNP) + (size_t)jl * T * 64;
    const bf16_t* wsb = (const bf16_t*)(P.ws + WS_SGUWS) + (size_t)jl * 8 * 128 * 128;
    const float* lng = P.in[I_SGU_LNG] + jl * SGU_W; const float* lnb = P.in[I_SGU_LNB] + jl * SGU_W;
    const float* bs = P.in[I_SGU_BS] + jl * 8 * 128;
    const int step = (int)(gridDim.x >> 3), ubase = (vc & 7) * 128;
    int ui_ = vc >> 3, gcur = -1;
    if (ui_ >= 128) return;
    S2Pre nx;
    s2_load(nx, z, lnstat, ubase + ui_, tid, wave, l15, lq);
    for (;;) {
        const int u = ubase + ui_, g = u & 7;
        __syncthreads();
        if (g != gcur) {
#pragma unroll
            for (int i = 0; i < 4; ++i) { const int q = tid + NTHREADS * i, t = q >> 4, cc = q & 15; *(LAS u32x4*)(Wl + t * 272 + cc * 16) = *(const u32x4*)(wsb + (size_t)g * 16384 + t * 128 + cc * 8); }
            gcur = g;
        }
        float gg[16], bb[16], bias8[8];
        { const int col = g * SGC + (tid & 15) * 16;
#pragma unroll
          for (int e = 0; e < 16; ++e) { gg[e] = lng[col + e]; bb[e] = lnb[col + e]; }
#pragma unroll
          for (int tt = 0; tt < 8; ++tt) bias8[tt] = bs[g * 128 + 16 * tt + l15]; }
        if (ui_ + step < 128) { s2_unit<true>(nx, z, ug, lnstat, gg, bb, bias8, lds, u, u + step, tid, wave, l15, lq); ui_ += step; }
        else { s2_unit<false>(nx, z, ug, lnstat, gg, bb, bias8, lds, u, u, tid, wave, l15, lq); break; }
    }
}

DEVI void phase_router(const Params& P, int wv, int vc, unsigned char* lds, int layer) {
    const int tid = opaque_tid(), lane = tid & 63, wave = tid >> 6, l15 = lane & 15, lq = lane >> 4;
    LAS unsigned char* Bw = (LAS unsigned char*)lds;
    float* red = (float*)(lds + 132096);
    float* lgt = (float*)(lds + 144384);
    float* ssqt = (float*)(lds + 152576);
    int* r_cls = (int*)(lds + 152832);
    float* r_wlo = (float*)(lds + 152832 + 256);
    float* r_whi = (float*)(lds + 152832 + 512);
    float* r_rs = (float*)(lds + 152832 + 768);
    int* c_base = (int*)(lds + 152832 + 1024);
    const bf16_t* wr = (const bf16_t*)(P.ws + WS_WR) + (size_t)layer * 2 * 32 * D;
    const bf16_t* h = (const bf16_t*)(P.ws + WS_HB1);
    int* cnt = (int*)(P.ws + CTL_CNT) + layer * 32 * CNT_STRIDE;
    int* list = (int*)(P.ws + WS_LIST);
    f32x4* tokinfo = (f32x4*)(P.ws + WS_TOKINFO);
    float brg[4], bre[16];
#pragma unroll
    for (int g = 0; g < 4; ++g) brg[g] = P.in[I_BRG][layer * 4 + g];
#pragma unroll
    for (int e = 0; e < 16; ++e) bre[e] = P.in[I_BRE][layer * 16 + e];
    const int rstep = (int)(gridDim.x >> 3);
    bf16x8 av[16];
    {
        const int bi0 = vc >> 3;
        if (bi0 < 32) {
            const bf16_t* ap = h + (size_t)(((vc & 7) * 32 + bi0) * 64 + 16 * (wave & 3) + l15) * D + (wave >> 2) * 512 + 8 * lq;
#pragma unroll
            for (int ks = 0; ks < 16; ++ks) av[ks] = *(const bf16x8*)(ap + 32 * ks);
        }
    }
    {
        u32x4 wv4[16];
#pragma unroll
        for (int i = 0; i < 16; ++i) wv4[i] = ((const u32x4*)wr)[tid + NTHREADS * i];
#pragma unroll
        for (int i = 0; i < 16; ++i) { const int q = tid + NTHREADS * i; *(LAS u32x4*)(Bw + (q >> 7) * 2064 + (q & 127) * 16) = wv4[i]; }
    }
    __syncthreads();
    for (int bi_ = vc >> 3; bi_ < 32; bi_ += rstep) {
        const int blk = (vc & 7) * 32 + bi_;
        {
            const int mt = wave & 3, kh = wave >> 2;
            const LAS unsigned char* bp = Bw + l15 * 2064 + (kh * 512 + 8 * lq) * 2;
            f32x4 acc0 = (f32x4){0.f, 0.f, 0.f, 0.f}, acc1 = (f32x4){0.f, 0.f, 0.f, 0.f}; float ss = 0.f;
            bf16x8 ac[16];
#pragma unroll
            for (int ks = 0; ks < 16; ++ks) ac[ks] = av[ks];
            if (bi_ + rstep < 32) {
                const bf16_t* ap = h + (size_t)(((vc & 7) * 32 + bi_ + rstep) * 64 + 16 * mt + l15) * D + kh * 512 + 8 * lq;
#pragma unroll
                for (int ks = 0; ks < 16; ++ks) av[ks] = *(const bf16x8*)(ap + 32 * ks);
            }
#pragma unroll
            for (int ks = 0; ks < 16; ++ks) {
                const bf16x8 a = ac[ks];
                const u32x4 aw = __builtin_bit_cast(u32x4, a);
                ss += bflo(aw.x) * bflo(aw.x) + bfhi(aw.x) * bfhi(aw.x) + bflo(aw.y) * bflo(aw.y) + bfhi(aw.y) * bfhi(aw.y) + bflo(aw.z) * bflo(aw.z) + bfhi(aw.z) * bfhi(aw.z) + bflo(aw.w) * bflo(aw.w) + bfhi(aw.w) * bfhi(aw.w);
                acc0 = mfma16(*(const LAS bf16x8*)(bp + 64 * ks), a, acc0);
                acc0 = mfma16(*(const LAS bf16x8*)(bp + 32 * 2064 + 64 * ks), a, acc0);
                acc1 = mfma16(*(const LAS bf16x8*)(bp + 16 * 2064 + 64 * ks), a, acc1);
                acc1 = mfma16(*(const LAS bf16x8*)(bp + 48 * 2064 + 64 * ks), a, acc1);
            }
            ss += __shfl_xor(ss, 16); ss += __shfl_xor(ss, 32);
            __syncthreads();
            if (kh == 1) { float* rp = red + (mt * 64 + lane) * 12; *(f32x4*)rp = acc0; *(f32x4*)(rp + 4) = acc1; rp[8] = ss; }
            __syncthreads();
            if (kh == 0) {
                const float* rp = red + (mt * 64 + lane) * 12;
                acc0 += *(const f32x4*)rp; acc1 += *(const f32x4*)(rp + 4); ss += rp[8];
                float* lp = lgt + (16 * mt + l15) * 32 + 4 * lq;
                *(f32x4*)lp = acc0; *(f32x4*)(lp + 16) = acc1;
                if (lq == 0) ssqt[16 * mt + l15] = ss;
            }
            __syncthreads();
        }
        if (tid < 64) {
            const int rl = tid;
            const float rs = rstd_from_ssq(ssqt[rl]);
            float lg[20];
#pragma unroll
            for (int o = 0; o < 20; ++o) lg[o] = lgt[rl * 32 + o] * rs;
            float gl[4]; int gi = 0;
#pragma unroll
            for (int g = 0; g < 4; ++g) gl[g] = lg[g] + brg[g];
            float gm = gl[0];
#pragma unroll
            for (int g = 1; g < 4; ++g) if (gl[g] > gm) { gm = gl[g]; gi = g; }
            float den = 0.f;
#pragma unroll
            for (int g = 0; g < 4; ++g) den += __expf(gl[g] - gm);
            const float gw = 1.0f / den;
            float el[4];
#pragma unroll
            for (int e = 0; e < 4; ++e) {
                float v = lg[4 + e] + bre[e];
                v = gi == 1 ? lg[8 + e] + bre[4 + e] : v; v = gi == 2 ? lg[12 + e] + bre[8 + e] : v; v = gi == 3 ? lg[16 + e] + bre[12 + e] : v;
                el[e] = v;
            }
            int i1 = 0; float v1 = el[0];
#pragma unroll
            for (int e = 1; e < 4; ++e) if (el[e] > v1) { v1 = el[e]; i1 = e; }
            int i2 = -1; float v2 = -3.0e38f;
#pragma unroll
            for (int e = 0; e < 4; ++e) if (e != i1 && el[e] > v2) { v2 = el[e]; i2 = e; }
            const float ex = __expf(v2 - v1); const float w1 = gw / (1.0f + ex), w2 = gw * ex / (1.0f + ex);
            const int lo = i1 < i2 ? i1 : i2, hi = i1 < i2 ? i2 : i1;
            const float wlo = i1 < i2 ? w1 : w2, whi = i1 < i2 ? w2 : w1;
            const int pair = lo == 0 ? hi - 1 : (lo == 1 ? hi + 1 : 5);
            r_cls[rl] = gi * 6 + pair; r_wlo[rl] = wlo; r_whi[rl] = whi; r_rs[rl] = rs;
        }
        __syncthreads();
        if (tid < NCLS) { int c = 0; for (int r = 0; r < 64; ++r) c += (r_cls[r] == tid) ? 1 : 0; c_base[tid] = c ? atomicAdd(cnt + tid * CNT_STRIDE, c) : 0; }
        __syncthreads();
        if (tid < 64) {
            const int c = r_cls[tid]; int rank = 0;
            for (int r = 0; r < tid; ++r) rank += (r_cls[r] == c) ? 1 : 0;
            const int row = blk * 64 + tid;
            list[(size_t)c * T + c_base[c] + rank] = row;
            tokinfo[row] = (f32x4){r_rs[tid], r_wlo[tid], r_whi[tid], 0.f};
        }
        __syncthreads();
    }
}

DEVI void phase_final(const Params& P, int wv, int vc) {
    const int tid = opaque_tid(), lane = tid & 63, wave = tid >> 6;
    const int lw = (vc >> 3) * NWAVES + wave, nlw = (int)(gridDim.x >> 3) * NWAVES, rbase = (vc & 7) * SEQ;
    const bf16_t* h = (const bf16_t*)(P.ws + WS_HB0); const float* g = P.in[I_FINAL];
    f32x4 gg[4];
#pragma unroll
    for (int q = 0; q < 4; ++q) gg[q] = *(const f32x4*)(g + (q >> 1) * 512 + 8 * lane + 4 * (q & 1));
    for (int r0 = lw; r0 < SEQ; r0 += 8 * nlw) {
        u32x4 w[8][2];
#pragma unroll
        for (int r = 0; r < 8; ++r) { const int rr = r0 + r * nlw; const u32x4* hr = (const u32x4*)(h + (size_t)(rbase + (rr < SEQ ? rr : 0)) * D) + lane; w[r][0] = hr[0]; w[r][1] = hr[64]; }
#pragma unroll
        for (int r = 0; r < 8; ++r) {
            const int rr = r0 + r * nlw; if (rr < SEQ) {
            const int row = rbase + rr;
            const u32x4 w0 = w[r][0], w1 = w[r][1];
            float v[16] = {bflo(w0.x), bfhi(w0.x), bflo(w0.y), bfhi(w0.y), bflo(w0.z), bfhi(w0.z), bflo(w0.w), bfhi(w0.w), bflo(w1.x), bfhi(w1.x), bflo(w1.y), bfhi(w1.y), bflo(w1.z), bfhi(w1.z), bflo(w1.w), bfhi(w1.w)};
            float ss = 0.f;
#pragma unroll
            for (int j = 0; j < 16; ++j) ss += v[j] * v[j];
            ss = wave_sum(ss);
            const float rs = rstd_from_ssq(ss);
#pragma unroll
            for (int q = 0; q < 4; ++q) {
                const int col = (q >> 1) * 512 + 8 * lane + 4 * (q & 1);
                *(f32x4*)(P.out + (size_t)row * D + col) = (f32x4){v[4 * q] * rs * gg[q].x, v[4 * q + 1] * rs * gg[q].y, v[4 * q + 2] * rs * gg[q].z, v[4 * q + 3] * rs * gg[q].w};
            }
            }
        }
    }
}

DEVI float* ssq_ptr(const Params& P, int wv, int vc, int layer, int which) { return (float*)(P.ws + WS_SSQP) + (size_t)(layer * 2 + which) * T * 16; }

DEVI void phase_g1_gemm(const Params& P, int wv, int vc, unsigned char* lds, int jl, int layer) {
    PlainSched S; S.init((const bf16_t*)(P.ws + WS_HB0), D, (const bf16_t*)(P.ws + WS_GLA_IN) + (size_t)jl * GLA_IN * D, D, T, GLA_Z, gridDim.x, vc);
    const RstdHook<PlainSched> hook{wv, lds, &S, ssq_ptr(P, wv, vc, layer, 0)};
    EpiZ E{(bf16_t*)(P.ws + WS_ZBUF), GLA_Z, (const LAS float*)((LAS unsigned char*)lds + LDS_RTAB), 0, nullptr, 0};
    gemm_run<false>(wv, lds, GemmShape{D, D, D, D, false}, S, E, hook);
}
DEVI void phase_s1_gemm(const Params& P, int wv, int vc, unsigned char* lds, int jl, int layer) {
    PlainSched S; S.init((const bf16_t*)(P.ws + WS_HB0), D, (const bf16_t*)(P.ws + WS_SGU_IN) + (size_t)jl * SGU_Z * D, D, T, SGU_Z, gridDim.x, vc);
    const RstdHook<PlainSched> hook{wv, lds, &S, ssq_ptr(P, wv, vc, layer, 0)};
    EpiZT<true> E{(bf16_t*)(P.ws + WS_ZBUF), SGU_Z, (const LAS float*)((LAS unsigned char*)lds + LDS_RTAB), 1, (float*)(P.ws + WS_LNP) + (size_t)jl * T * 64, 8};
    gemm_run<false>(wv, lds, GemmShape{D, D, D, D, false}, S, E, hook);
}
DEVI void phase_mixout_gemm(const Params& P, int wv, int vc, unsigned char* lds, int jl, int layer, bool gla) {
    EpiRes<false> E{(const bf16_t*)(P.ws + WS_HB0), (bf16_t*)(P.ws + WS_HB1), nullptr, nullptr, nullptr};
    PlainSched S;
    if (gla) { S.init((const bf16_t*)(P.ws + WS_ZBUF + ZB_OB), D, (const bf16_t*)(P.ws + WS_GLA_OUT) + (size_t)jl * D * D, D, T, D, gridDim.x, vc); gemm_run<false>(wv, lds, GemmShape{D, D, D, D, false}, S, E); }
    else { S.init((const bf16_t*)(P.ws + WS_BUF2), SGU_W, (const bf16_t*)(P.ws + WS_SGU_OUT) + (size_t)jl * D * SGU_W, SGU_W, T, D, gridDim.x, vc); gemm_run<false>(wv, lds, GemmShape{SGU_W, SGU_W, SGU_W, SGU_W, false}, S, E); }
}
struct FillSched {
    const bf16_t* A; const bf16_t* Bt; int lda, ldb, j, stride, ntot;
    DEVI bool next(int i, Unit& u) const {
        if (j < 0) return false;
        const int un = j + i * stride; if (un >= ntot) return false;
        u.pm = un >> 2; u.pn = un & 3; u.A = A + (size_t)u.pm * 256 * lda; u.rows = nullptr; u.nvalid = 256; u.B0 = Bt + (size_t)u.pn * 256 * ldb; u.B1 = u.B0; u.aux0 = 0; u.aux1 = 0; u.idx = i;
        return true;
    }
};
DEVI void phase_pleup_gemm(const Params& P, int wv, int vc, unsigned char* lds, int layer, int n_gemm_units, bool grp) {
    int G = gridDim.x, c = vc;
    int j, stride;
    if (grp) {
        const int ntile_all = __builtin_amdgcn_readfirstlane(((const LAS int*)((LAS unsigned char*)lds + LDS_SCHED))[NCLS]);
        const int G32 = G >> 3, x = vc & 7, rank = vc >> 3, q = ntile_all >> 3, rem = ntile_all & 7;
        int idle_before = 0, idle_total = 0, my_c0 = G32;
#pragma unroll 1
        for (int xx = 0; xx < 8; ++xx) {
            const int nt = q + (xx < rem ? 1 : 0), n2 = 8 * nt, n3 = 4 * nt;
            const int nA = n2 < 2 * G32 ? n2 : 2 * G32, nB = n2 - nA, wB = nB < G32 ? nB : G32, dB = (G32 - wB) < n3 ? (G32 - wB) : n3, nC = n3 - dB;
            const int idle = nC < G32 ? G32 - nC : 0;
            if (xx < x) idle_before += idle;
            if (xx == x) my_c0 = nC < G32 ? nC : G32;
            idle_total += idle;
        }
        if (3 * idle_total >= 256) { j = rank >= my_c0 ? idle_before + rank - my_c0 : -1; stride = idle_total; }
        else { j = vc; stride = G; }
        (void)n_gemm_units; (void)c;
    } else {
        int c0 = __builtin_amdgcn_readfirstlane(n_gemm_units); while (c0 > G) c0 -= G;
        if (3 * (G - c0) >= G) { j = c >= c0 ? c - c0 : -1; stride = G - c0; }
        else { j = c; stride = G; }
    }
    FillSched S{(const bf16_t*)(P.ws + WS_PB), (const bf16_t*)(P.ws + WS_PLE_UP) + (size_t)layer * D * PLE, PLE, PLE, j, stride, 256};
    EpiZ E{(bf16_t*)(P.ws + WS_UPLE), D, nullptr, 0, nullptr, 0};
    gemm_run<false>(wv, lds, GemmShape{PLE, PLE, PLE, PLE, false}, S, E);
}
DEVI void phase_moe_up(const Params& P, int wv, int vc, unsigned char* lds, int layer, int mode, bool grp) {
    LAS int* pre = (LAS int*)((LAS unsigned char*)lds + LDS_SCHED); LAS int* cn = pre + 32; LAS int* rl = pre + 64;
    (void)moe_sched_setup(P, wv, vc, layer, pre, cn, rl, 8, mode, grp);
    MoeSched S{pre, cn, rl, 8, (int)gridDim.x, vc, true, (const bf16_t*)(P.ws + WS_HB1), (const bf16_t*)(P.ws + WS_MOE_UP)};
    EpiAct E{(bf16_t*)(P.ws + WS_ZBUF), (const f32x4*)(P.ws + WS_TOKINFO)};
    gemm_run<true>(wv, lds, GemmShape{D, D, D, D, true}, S, E, NoHook{}, MoeListHook{wv, pre, cn, rl, (const int*)(P.ws + WS_LIST), true});
}
DEVI int phase_moe_down(const Params& P, int wv, int vc, unsigned char* lds, int layer, int mode, bool grp) {
    LAS int* pre = (LAS int*)((LAS unsigned char*)lds + LDS_SCHED); LAS int* cn = pre + 32; LAS int* rl = pre + 64;
    const int N = moe_sched_setup(P, wv, vc, layer, pre, cn, rl, 4, mode, grp);
    MoeSched S{pre, cn, rl, 4, (int)gridDim.x, vc, false, (const bf16_t*)(P.ws + WS_ZBUF), (const bf16_t*)(P.ws + WS_MOE_DN)};
    EpiRes<false> E{(const bf16_t*)(P.ws + WS_HB1), (bf16_t*)(P.ws + WS_HB1), ssq_ptr(P, wv, vc, layer, 1), nullptr, nullptr};
    gemm_run<false>(wv, lds, GemmShape{1024, 512, 1024, 512, false}, S, E, MoeListHook{wv, pre, cn, rl, (const int*)(P.ws + WS_LIST), false});
    return N;
}
DEVI void phase_ple_gemm(const Params& P, int wv, int vc, unsigned char* lds, int layer) {
    PlainSched S; S.init((const bf16_t*)(P.ws + WS_HB1), D, (const bf16_t*)(P.ws + WS_PLE_GATE) + (size_t)layer * D * D, D, T, D, gridDim.x, vc);
    const RstdHook<PlainSched> hook{wv, lds, &S, ssq_ptr(P, wv, vc, layer, 1)};
    EpiRes<true> E{(const bf16_t*)(P.ws + WS_HB1), (bf16_t*)(P.ws + WS_HB0), layer < NLAYER - 1 ? ssq_ptr(P, wv, vc, layer + 1, 0) : nullptr, (const bf16_t*)(P.ws + WS_UPLE), (const LAS float*)((LAS unsigned char*)lds + LDS_RTAB)};
    gemm_run<false>(wv, lds, GemmShape{D, D, D, D, false}, S, E, hook);
}

#define XB_TMO      128
#define XB_XCNT(j)  (256  + 64 * (j))
#define XB_XSUB(j)  (1280 + 64 * (j))
#define XB_XGEN(j)  (2304 + 64 * (j))
#define XB_TOP      3328
#define XB_TOPGEN   3392
#define XCD_BAR_WORDS 3456
#define XB_SPIN_CAP (1u << 18)
__device__ __forceinline__ unsigned xb_ld(unsigned* p)              { return __hip_atomic_load(p, __ATOMIC_RELAXED, __HIP_MEMORY_SCOPE_AGENT); }
__device__ __forceinline__ unsigned xb_add(unsigned* p, unsigned v) { return __hip_atomic_fetch_add(p, v, __ATOMIC_RELAXED, __HIP_MEMORY_SCOPE_AGENT); }
__device__ __forceinline__ unsigned xb_xcc_id() { return (unsigned)__builtin_amdgcn_s_getreg((3 << 11) | 20) & 0xFu; }
#define XB_SPIN(cond, bar) do { unsigned _sp = 0; while (cond) { __builtin_amdgcn_s_sleep(1); \
    if ((++_sp & 255u) == 0u) { if (xb_ld(&(bar)[XB_TMO])) break; if (_sp > XB_SPIN_CAP) { atomicAdd(&(bar)[XB_TMO], 1u); break; } } } } while (0)
struct XcdBarrier {
    unsigned* bar; unsigned x;
    volatile LAS unsigned* st;
};
__device__ __forceinline__ XcdBarrier xcd_barrier_post(unsigned* bar, volatile LAS unsigned* st) {
    XcdBarrier b; b.bar = bar; b.x = (unsigned)__builtin_amdgcn_readfirstlane((int)xb_xcc_id()); b.st = st;
    if (threadIdx.x == 0) (void)xb_add(&bar[XB_XCNT(b.x)], 1u);
    return b;
}
__device__ __forceinline__ void xcd_barrier_complete(unsigned* bar, unsigned x, unsigned& nloc, unsigned& nx) {
    const unsigned G = gridDim.x * gridDim.y * gridDim.z;
    unsigned sum, cnt, mine, sp = 0u;
    for (;;) {
        sum = 0u; cnt = 0u; mine = 0u;
#pragma unroll
        for (unsigned j = 0; j < 16; ++j) { const unsigned c = xb_ld(&bar[XB_XCNT(j)]); sum += c; cnt += (c > 0u) ? 1u : 0u; mine = (j == x) ? c : mine; }
        if (sum == G) break;
        __builtin_amdgcn_s_sleep(1);
        if ((++sp & 255u) == 0u) { if (xb_ld(&bar[XB_TMO])) break; if (sp > XB_SPIN_CAP) { atomicAdd(&bar[XB_TMO], 1u); break; } }
    }
    nloc = mine > 0u ? mine : 1u; nx = cnt > 0u ? cnt : 1u;
}
__device__ __forceinline__ void xcd_barrier(const XcdBarrier& b) {
    asm volatile("s_waitcnt vmcnt(0)" ::: "memory");
    __syncthreads();
    if (threadIdx.x == 0) {
        unsigned* bar = b.bar; unsigned bx = b.x;
        asm volatile("" : "+s"(bar), "+s"(bx));
        __builtin_amdgcn_s_waitcnt(0);
        unsigned nloc = b.st[0], nx = b.st[1];
        if (nloc == 0u) { xcd_barrier_complete(bar, bx, nloc, nx); b.st[0] = nloc; b.st[1] = nx; }
        const unsigned old = xb_add(&bar[XB_XSUB(bx)], 1u);
        const unsigned gen = old / nloc;
        if (old + 1u == (gen + 1u) * nloc) {
            __builtin_amdgcn_fence(__ATOMIC_RELEASE, "agent");
            asm volatile("s_waitcnt vmcnt(0)" ::: "memory");
            const unsigned og = xb_add(&bar[XB_TOP], 1u);
            const unsigned tg = og / nx;
            if (og + 1u == (tg + 1u) * nx) xb_add(&bar[XB_TOPGEN], 1u);
            else XB_SPIN(xb_ld(&bar[XB_TOPGEN]) == tg, bar);
            __builtin_amdgcn_fence(__ATOMIC_ACQUIRE, "agent");
            xb_add(&bar[XB_XGEN(bx)], 1u);
            asm volatile("s_waitcnt vmcnt(0)" ::: "memory");
        } else {
            XB_SPIN(xb_ld(&bar[XB_XGEN(bx)]) == gen, bar);
            __builtin_amdgcn_fence(__ATOMIC_ACQUIRE, "agent");
            asm volatile("s_waitcnt vmcnt(0)" ::: "memory");
        }
    }
    __syncthreads();
}

constexpr size_t CTL_ROLE = 98304;
constexpr size_t CTL_LB = 106496;
__device__ __forceinline__ void xcd_local_barrier(unsigned* cw, unsigned target, unsigned* tmo_bar) {
    asm volatile("s_waitcnt vmcnt(0)" ::: "memory");
    __syncthreads();
    if (threadIdx.x == 0) {
        asm volatile("" : "+s"(cw));
        (void)xb_add(cw, 1u);
        asm volatile("buffer_inv sc1" ::: "memory");
        XB_SPIN(xb_ld(cw) < target, tmo_bar);
        asm volatile("s_waitcnt vmcnt(0)" ::: "memory");
    }
    __syncthreads();
}

#ifndef FORCE_GLOBAL_BARRIERS
#define FORCE_GLOBAL_BARRIERS 0
#endif
__global__ void __launch_bounds__(NTHREADS, 2) mega(Params P) {
    extern __shared__ __attribute__((aligned(16))) unsigned char lds[];
    const int wv = __builtin_amdgcn_readfirstlane((int)(threadIdx.x >> 6));
    volatile LAS unsigned* xbw = (volatile LAS unsigned*)((LAS unsigned char*)lds + LDS_XB);
    if (threadIdx.x < 4) xbw[threadIdx.x] = 0u;
    __syncthreads();
    const unsigned myx = (unsigned)__builtin_amdgcn_readfirstlane((int)xb_xcc_id());
    if (threadIdx.x == 0) xbw[2] = xb_add((unsigned*)(P.ws + CTL_ROLE) + 64 * myx, 1u);
    const XcdBarrier bar = xcd_barrier_post((unsigned*)(P.ws + CTL_BAR), xbw);
    int vc = blockIdx.x;
    phase_prologue(P, wv, vc, lds);
    xcd_barrier(bar);
    bool uniform = false;
    {
        const unsigned G8 = gridDim.x >> 3; unsigned okc = 0;
#pragma unroll
        for (unsigned j = 0; j < 8; ++j) okc += (xb_ld((unsigned*)(P.ws + CTL_ROLE) + 64 * j) == G8) ? 1u : 0u;
        uniform = !FORCE_GLOBAL_BARRIERS && (gridDim.x & 7u) == 0u && okc == 8u && myx < 8u;
        uniform = __builtin_amdgcn_readfirstlane((int)uniform) != 0;
        if (uniform) vc = (int)(xbw[2] * 8u + myx);
        vc = __builtin_amdgcn_readfirstlane(vc);
    }
    unsigned* lbw = (unsigned*)(P.ws + CTL_LB) + 64 * myx;
    const unsigned nloc = gridDim.x >> 3; unsigned lb_target = 0u;
#define LBAR() do { if (uniform) { lb_target += nloc; xcd_local_barrier(lbw, lb_target, (unsigned*)(P.ws + CTL_BAR)); } else xcd_barrier(bar); } while (0)
#pragma unroll 1
    for (int layer = 0; layer < NLAYER; ++layer) {
        const int jl = layer >> 1;
        const bool pre_first = ((vc & 1) == 0) || !uniform;
        if (pre_first) phase_layer_pre(P, wv, vc, lds, layer);
        if ((layer & 1) == 0) {
            phase_g1_gemm(P, wv, vc, lds, jl, layer); phase_aproj(P, wv, vc, lds, jl, layer);
            LBAR();
            phase_g2_fast(P, wv, vc, lds, jl);
            LBAR();
            phase_g3(P, wv, vc, lds);
            LBAR();
            phase_g4_fast(P, wv, vc, lds, jl);
            LBAR();
            phase_mixout_gemm(P, wv, vc, lds, jl, layer, true);
        } else {
            phase_s1_gemm(P, wv, vc, lds, jl, layer);
            LBAR();
            phase_s2_fast(P, wv, vc, lds, jl);
            LBAR();
            phase_mixout_gemm(P, wv, vc, lds, jl, layer, false);
        }
        if (!pre_first) phase_layer_pre(P, wv, vc, lds, layer);
        LBAR();
        phase_router(P, wv, vc, lds, layer);
        xcd_barrier(bar);
        phase_moe_up(P, wv, vc, lds, layer, MOE_UP_A, uniform);
        LBAR();
        phase_moe_up(P, wv, vc, lds, layer, MOE_UP_B, uniform);
        (void)phase_moe_down(P, wv, vc, lds, layer, MOE_DN_B, uniform);
        LBAR();
        {
            const int nC = phase_moe_down(P, wv, vc, lds, layer, MOE_DN_C, uniform);
            phase_pleup_gemm(P, wv, vc, lds, layer, nC, uniform);
        }
        xcd_barrier(bar);
        phase_ple_gemm(P, wv, vc, lds, layer);
        LBAR();
    }
    phase_final(P, wv, vc);
}

extern "C" void kernel_launch(void* const* d_in, const int* in_sizes, int n_in, void* d_out, int out_size, void* d_ws, size_t ws_size, hipStream_t stream) {
    static int grid = 0;
    if (grid == 0) {
        if (n_in != 26 || ws_size < WS_END) { fprintf(stderr, "kernel_launch: unexpected n_in %d or ws_size %zu\n", n_in, ws_size); grid = -1; return; }
        int dev = 0, cus = 0;
        if (hipGetDevice(&dev) != hipSuccess || hipDeviceGetAttribute(&cus, hipDeviceAttributeMultiprocessorCount, dev) != hipSuccess) { grid = -1; return; }
        if (hipFuncSetAttribute((const void*)mega, hipFuncAttributeMaxDynamicSharedMemorySize, LDS_BYTES) != hipSuccess) { fprintf(stderr, "kernel_launch: hipFuncSetAttribute failed\n"); grid = -1; return; }
        grid = cus < 256 ? cus : 256;
    }
    if (grid < 0) return;
    Params P{};
    for (int i = 0; i < 26; ++i) P.in[i] = (const float*)d_in[i];
    P.out = (float*)d_out; P.ws = (unsigned char*)d_ws;
    (void)hipMemsetAsync((char*)d_ws + WS_CTL, 0, CTL_BYTES, stream);
    hipLaunchKernelGGL(mega, dim3(grid), dim3(NTHREADS), LDS_BYTES, stream, P);
}
```

```cpp
#include <hip/hip_runtime.h>
#include <stdint.h>
#include <stdio.h>

#define DEVI __device__ __forceinline__
#define LAS __attribute__((address_space(3)))
#ifndef USE_FAST
#define USE_FAST 1
#endif
#ifndef PROBE
#define PROBE 0
#endif
#define PB(k, stmt) do { stmt; if (PROBE == (k)) { __syncthreads(); stmt; } } while (0)
#define XBAR() do { xcd_barrier(bar); if (PROBE == 4) xcd_barrier(bar); } while (0)
typedef unsigned short bf16_t;
typedef short bf16x8 __attribute__((ext_vector_type(8)));
typedef float f32x4 __attribute__((ext_vector_type(4)));
typedef float f32x2 __attribute__((ext_vector_type(2)));
typedef unsigned u32x4 __attribute__((ext_vector_type(4)));
typedef unsigned u32x2 __attribute__((ext_vector_type(2)));

constexpr int T = 16384, D = 1024, SEQ = 2048, NLAYER = 4;
constexpr int GLA_IN = 3088, GLA_Z = 3072, HK = 128, HV = 256, GCH = 64, GNC = 32;
constexpr int SGU_Z = 4096, SGU_W = 2048, SGC = 256, SCH = 128, SNC = 16;
constexpr int NCLS = 24, FF = 512, PLE = 256;
constexpr float EPS = 1e-6f;
constexpr int NTHREADS = 512, NWAVES = 8;

constexpr size_t MiB = 1u << 20;
constexpr size_t WS_CTL = 0, CTL_BYTES = 1 * MiB;
constexpr size_t CTL_CNT = 131072;
constexpr int CNT_STRIDE = 64;
constexpr size_t CTL_BAR = 65536;
constexpr int LDS_STAGE = 0;
constexpr int LDS_SCHED = 131072;
constexpr int LDS_XB = 155632;
constexpr int LDS_BYTES = 155648;
constexpr size_t WS_TOKINFO = 1 * MiB;
constexpr size_t WS_LIST = 2 * MiB;
constexpr size_t WS_AGATE = 4 * MiB;
constexpr size_t WS_BEND = 5 * MiB;
constexpr size_t WS_WR = 6 * MiB;
constexpr size_t WS_SGUWS = 7 * MiB;
constexpr size_t WS_GLA_IN = 8 * MiB;
constexpr size_t WS_GLA_OUT = 21 * MiB;
constexpr size_t WS_SGU_IN = 25 * MiB;
constexpr size_t WS_SGU_OUT = 41 * MiB;
constexpr size_t WS_PLE_GATE = 49 * MiB;
constexpr size_t WS_PLE_UP = 57 * MiB;
constexpr size_t WS_MOE_UP = 60 * MiB;
constexpr size_t WS_MOE_DN = 92 * MiB;
constexpr size_t WS_UPLE = 108 * MiB;
constexpr size_t WS_HB0 = 172 * MiB;
constexpr size_t WS_HB1 = 204 * MiB;
constexpr size_t WS_ZBUF = 236 * MiB;
constexpr size_t WS_BUF2 = 364 * MiB;
constexpr size_t WS_PB = 428 * MiB;
constexpr size_t WS_SSQP = 436 * MiB;
constexpr size_t WS_LNP = 444 * MiB;
constexpr size_t WS_END = 452 * MiB;
constexpr size_t ZB_OB = (size_t)T * GLA_Z * 2;
constexpr size_t ZB_UPLE = 48 * MiB;
constexpr int ACT_ROWS = 88 * 256;

struct Params {
    const float* in[26];
    float* out;
    unsigned char* ws;
};
enum { I_X = 0, I_P, I_GLA_WIN, I_GLA_WGU, I_GLA_BG, I_GLA_GH, I_GLA_WOUT, I_SGU_WIN, I_SGU_LNG, I_SGU_LNB, I_SGU_WS, I_SGU_BS, I_SGU_WOUT,
       I_NMIX, I_NFFN, I_NPLE, I_WRG, I_BRG, I_WRE, I_BRE, I_MOE_WG, I_MOE_WU, I_MOE_WD, I_PLE_WUP, I_PLE_WG, I_FINAL };

DEVI int opaque_tid_(int wv) { int l; asm volatile("v_mbcnt_lo_u32_b32 %0, -1, 0\n\tv_mbcnt_hi_u32_b32 %0, -1, %0" : "=v"(l)); return (wv << 6) | l; }
#define opaque_tid() opaque_tid_(wv)
DEVI unsigned f2bf(float f) { unsigned u = __float_as_uint(f); return (u + 0x7fffu + ((u >> 16) & 1u)) >> 16; }
DEVI float bf2f(unsigned b) { return __uint_as_float(b << 16); }
DEVI unsigned pk2(float lo, float hi) { return f2bf(lo) | (f2bf(hi) << 16); }
DEVI float bflo(unsigned w) { return __uint_as_float(w << 16); }
DEVI float bfhi(unsigned w) { return __uint_as_float(w & 0xffff0000u); }
DEVI float wave_sum(float v) {
#pragma unroll
    for (int o = 1; o < 64; o <<= 1) v += __shfl_xor(v, o);
    return v;
}
DEVI float sigmoidf_(float x) { return __builtin_amdgcn_rcpf(1.0f + __expf(-x)); }
DEVI float siluf_(float x) { return x * sigmoidf_(x); }
DEVI float gelu_tanh(float x) {
    const float y = 0.7978845608028654f * (x + 0.044715f * x * x * x);
    return x * __builtin_amdgcn_rcpf(1.0f + __expf(-2.0f * y));
}
DEVI float logsigmoidf_(float x) { return fminf(x, 0.0f) - __logf(1.0f + __expf(-fabsf(x))); }
DEVI float rstd_from_ssq(float ssq) { return rsqrtf(ssq * (1.0f / D) + EPS); }
DEVI float rstd16s(const float* ssq, int row) {
    float v[16];
#pragma unroll
    for (int k = 0; k < 16; ++k) v[k] = ssq[(size_t)k * T + row];
    const float s = (((v[0] + v[1]) + (v[2] + v[3])) + ((v[4] + v[5]) + (v[6] + v[7]))) + (((v[8] + v[9]) + (v[10] + v[11])) + ((v[12] + v[13]) + (v[14] + v[15])));
    return rstd_from_ssq(s);
}
DEVI float rstd16(const float* p) {
    const f32x4 a = *(const f32x4*)p, b = *(const f32x4*)(p + 4), c = *(const f32x4*)(p + 8), d = *(const f32x4*)(p + 12);
    const float s = ((a.x + a.y) + (a.z + a.w)) + ((b.x + b.y) + (b.z + b.w)) + ((c.x + c.y) + (c.z + c.w)) + ((d.x + d.y) + (d.z + d.w));
    return rstd_from_ssq(s);
}

DEVI void tr_item(const float* W, int K, int N, const float* gain, bf16_t* WT, int k0, int n0, int nvalid, int rowbase, float* scr, int lane) {
    const int n = lane & 31, hi = lane >> 5;
    float v[32];
    const float gv = gain ? gain[k0 + lane] : 1.0f;
    const float* src = W + (size_t)(k0 + hi) * N + n0 + n;
#pragma unroll
    for (int i = 0; i < 32; ++i) v[i] = (n < nvalid) ? src[(size_t)(2 * i) * N] : 0.f;
#pragma unroll
    for (int i = 0; i < 32; ++i) scr[(2 * i + hi) * 33 + n] = v[i] * __shfl(gv, 2 * i + hi);
    asm volatile("s_waitcnt lgkmcnt(0)" ::: "memory");
    const int c = lane & 7;
#pragma unroll
    for (int j = 0; j < 4; ++j) {
        const int nn = (lane >> 3) + 8 * j; const float* sp = scr + (8 * c) * 33 + nn;
        u32x4 o; o.x = pk2(sp[0 * 33], sp[1 * 33]); o.y = pk2(sp[2 * 33], sp[3 * 33]); o.z = pk2(sp[4 * 33], sp[5 * 33]); o.w = pk2(sp[6 * 33], sp[7 * 33]);
        if (nn < nvalid) *(u32x4*)(WT + (size_t)(rowbase + nn) * K + k0 + 8 * c) = o;
    }
    asm volatile("s_waitcnt lgkmcnt(0)" ::: "memory");
}
DEVI void conv_mat(const float* W, int K, int N, const float* gain, bf16_t* WT, int mode, int& off, int gw, int ngw, float* scr, int lane) {
    const int nnb = (N + 31) / 32, nitems = (K / 64) * nnb;
    const int first = gw - off < 0 ? gw - off + ngw : gw - off;
    for (int it = first; it < nitems; it += ngw) {
        const int kb = it / nnb, nb = it % nnb, n0 = 32 * nb, nvalid = (N - n0) < 32 ? (N - n0) : 32;
        const int rowbase = mode == 0 ? n0 : ((n0 >> 7) * 256 + (n0 & 127) + (mode == 2 ? 128 : 0));
        tr_item(W, K, N, gain, WT, 64 * kb, n0, nvalid, rowbase, scr, lane);
    }
    off += nitems; while (off >= ngw) off -= ngw;
}

struct CvDesc { const float* W; const float* gain; bf16_t* WT; int K, N, k0, n0, nvalid, rowbase; };
DEVI bool cv_decode(const Params& P, int layer, int id, CvDesc& d) {
    unsigned char* ws = P.ws;
    const float* W; const float* gain = nullptr; bf16_t* WT; int K, N, mode = 0, it, sh;
    if (layer < 0) {
        if (id < 1552) { it = id; W = P.in[I_GLA_WIN]; gain = P.in[I_NMIX]; WT = (bf16_t*)(ws + WS_GLA_IN); K = D; N = GLA_IN; sh = 0; }
        else if (id < 2064) { it = id - 1552; W = P.in[I_GLA_WOUT]; WT = (bf16_t*)(ws + WS_GLA_OUT); K = D; N = D; sh = 5; }
        else return false;
    } else if (id < 12288) {
        const int e = id / 768, r = id - e * 768, kind = r >> 8; it = r & 255;
        if (kind < 2) { W = (kind == 0 ? P.in[I_MOE_WG] : P.in[I_MOE_WU]) + ((size_t)layer * 16 + e) * D * FF; gain = P.in[I_NFFN] + layer * D; WT = (bf16_t*)(ws + WS_MOE_UP) + (size_t)e * 1024 * 1024; K = D; N = FF; mode = 1 + kind; sh = 4; }
        else { W = P.in[I_MOE_WD] + ((size_t)layer * 16 + e) * FF * D; WT = (bf16_t*)(ws + WS_MOE_DN) + (size_t)e * 1024 * 512; K = FF; N = D; sh = 5; }
    } else if (id < 12800) { it = id - 12288; W = P.in[I_PLE_WG] + (size_t)layer * D * D; gain = P.in[I_NPLE] + layer * D; WT = (bf16_t*)(ws + WS_PLE_GATE) + (size_t)layer * D * D; K = D; N = D; sh = 5; }
    else if (id < 12928) { it = id - 12800; W = P.in[I_PLE_WUP] + (size_t)layer * PLE * D; WT = (bf16_t*)(ws + WS_PLE_UP) + (size_t)layer * D * PLE; K = PLE; N = D; sh = 5; }
    else {
        const int nl = layer + 1, j = nl >> 1, r = id - 12928;
        if (nl >= NLAYER) return false;
        if ((nl & 1) == 0) {
            if (r < 1552) { it = r; W = P.in[I_GLA_WIN] + (size_t)j * D * GLA_IN; gain = P.in[I_NMIX] + nl * D; WT = (bf16_t*)(ws + WS_GLA_IN) + (size_t)j * GLA_IN * D; K = D; N = GLA_IN; sh = 0; }
            else if (r < 2064) { it = r - 1552; W = P.in[I_GLA_WOUT] + (size_t)j * D * D; WT = (bf16_t*)(ws + WS_GLA_OUT) + (size_t)j * D * D; K = D; N = D; sh = 5; }
            else return false;
        } else {
            if (r < 2048) { it = r; W = P.in[I_SGU_WIN] + (size_t)j * D * SGU_Z; gain = P.in[I_NMIX] + nl * D; WT = (bf16_t*)(ws + WS_SGU_IN) + (size_t)j * SGU_Z * D; K = D; N = SGU_Z; sh = 7; }
            else if (r < 3072) { it = r - 2048; W = P.in[I_SGU_WOUT] + (size_t)j * SGU_W * D; WT = (bf16_t*)(ws + WS_SGU_OUT) + (size_t)j * D * SGU_W; K = SGU_W; N = D; sh = 5; }
            else return false;
        }
    }
    const int kb = sh ? (it >> sh) : it / 97, nb = it - kb * (sh ? (1 << sh) : 97), n0 = 32 * nb;
    d.W = W; d.gain = gain; d.WT = WT; d.K = K; d.N = N; d.k0 = 64 * kb; d.n0 = n0; d.nvalid = (N - n0) < 32 ? (N - n0) : 32;
    d.rowbase = mode == 0 ? n0 : ((n0 >> 7) * 256 + (n0 & 127) + (mode == 2 ? 128 : 0));
    return true;
}
DEVI void cv_load(const CvDesc& d, float (&v)[32], float& gv, int lane) {
    const int n = lane & 31, hi = lane >> 5;
    gv = d.gain ? d.gain[d.k0 + lane] : 1.0f;
    const float* src = d.W + (size_t)(d.k0 + hi) * d.N + d.n0 + (n < d.nvalid ? n : d.nvalid - 1);
#pragma unroll
    for (int i = 0; i < 32; ++i) v[i] = src[(size_t)(2 * i) * d.N];
}
DEVI void cv_store(const CvDesc& d, const float (&v)[32], float gv, float* scr, int lane) {
    const int n = lane & 31, hi = lane >> 5;
#pragma unroll
    for (int i = 0; i < 32; ++i) scr[(2 * i + hi) * 33 + n] = v[i] * __shfl(gv, 2 * i + hi);
    asm volatile("s_waitcnt lgkmcnt(0)" ::: "memory");
    const int c = lane & 7;
#pragma unroll
    for (int j = 0; j < 4; ++j) {
        const int nn = (lane >> 3) + 8 * j; const float* sp = scr + (8 * c) * 33 + nn;
        u32x4 o; o.x = pk2(sp[0 * 33], sp[1 * 33]); o.y = pk2(sp[2 * 33], sp[3 * 33]); o.z = pk2(sp[4 * 33], sp[5 * 33]); o.w = pk2(sp[6 * 33], sp[7 * 33]);
        if (nn < d.nvalid) *(u32x4*)(d.WT + (size_t)(d.rowbase + nn) * d.K + d.k0 + 8 * c) = o;
    }
    asm volatile("s_waitcnt lgkmcnt(0)" ::: "memory");
}
DEVI void cv_run(const Params& P, int layer, int gw, int ngw, float* scr, int lane) {
    CvDesc da, db; float va[32], vb[32], ga = 1.0f, gb = 1.0f;
    int id = gw;
    bool ha = cv_decode(P, layer, id, da);
    if (ha) cv_load(da, va, ga, lane);
    while (ha) {
        id += ngw; const bool hb = cv_decode(P, layer, id, db); if (hb) cv_load(db, vb, gb, lane);
        cv_store(da, va, ga, scr, lane);
        if (!hb) break;
        id += ngw; ha = cv_decode(P, layer, id, da); if (ha) cv_load(da, va, ga, lane);
        cv_store(db, vb, gb, scr, lane);
    }
}

DEVI void phase_prologue(const Params& P, int wv, int vc, unsigned char* lds) {
    const int tid = opaque_tid(), lane = tid & 63, wave = wv;
    const int gw = vc * NWAVES + wave, ngw = gridDim.x * NWAVES;
    float* scr = (float*)(lds + wave * 8704);
    unsigned char* ws = P.ws;
    const float* x = P.in[I_X]; f32x4 v[8][4];
#pragma unroll
    for (int q = 0; q < 4; ++q) { const int row = gw + q * ngw; const f32x4* xr = (const f32x4*)(x + (size_t)(row < T ? row : 0) * D) + lane;
#pragma unroll
        for (int j = 0; j < 4; ++j) v[q][j] = xr[64 * j]; }
    cv_run(P, -1, gw, ngw, scr, lane);
    {
        const float* src = P.in[I_SGU_WS]; bf16_t* dst = (bf16_t*)(ws + WS_SGUWS);
        for (int idx = vc * NTHREADS + tid; idx < 2 * 8 * 128 * 128; idx += gridDim.x * NTHREADS) {
            const int s = idx & 127, t = (idx >> 7) & 127;
            dst[idx] = (bf16_t)f2bf(s <= t ? src[idx] : 0.f);
        }
    }
    {
        bf16_t* wr = (bf16_t*)(ws + WS_WR);
        for (int idx = vc * NTHREADS + tid; idx < NLAYER * 32 * D; idx += gridDim.x * NTHREADS) {
            const int k = idx % D, o = (idx / D) % 32, l = idx / (32 * D);
            float w = 0.f;
            if (o < 20) { const float g = P.in[I_NFFN][l * D + k]; w = g * ((o < 4) ? P.in[I_WRG][((size_t)l * D + k) * 4 + o] : P.in[I_WRE][((size_t)l * D + k) * 16 + (o - 4)]); }
            const unsigned hi = f2bf(w); const unsigned lo = f2bf(w - bf2f(hi));
            wr[((size_t)(l * 2 + 0) * 32 + o) * D + k] = (bf16_t)hi; wr[((size_t)(l * 2 + 1) * 32 + o) * D + k] = (bf16_t)lo;
        }
    }
    {
        bf16_t* hb0 = (bf16_t*)(ws + WS_HB0); float* ssq = (float*)(ws + WS_SSQP);
        for (int row0 = gw; row0 < T; row0 += 8 * ngw) {
#pragma unroll
            for (int q = 4; q < 8; ++q) { const int row = row0 + q * ngw; const f32x4* xr = (const f32x4*)(x + (size_t)(row < T ? row : 0) * D) + lane;
#pragma unroll
                for (int j = 0; j < 4; ++j) v[q][j] = xr[64 * j]; }
            if (row0 != gw) {
#pragma unroll
                for (int q = 0; q < 4; ++q) { const int row = row0 + q * ngw; const f32x4* xr = (const f32x4*)(x + (size_t)(row < T ? row : 0) * D) + lane;
#pragma unroll
                    for (int j = 0; j < 4; ++j) v[q][j] = xr[64 * j]; }
            }
#pragma unroll
            for (int q = 0; q < 8; ++q) {
                const int row = row0 + q * ngw; if (row < T) {
                float s = 0.f;
#pragma unroll
                for (int j = 0; j < 4; ++j) {
                    const f32x4 w = v[q][j];
                    s += w.x * w.x + w.y * w.y + w.z * w.z + w.w * w.w;
                    u32x2 o; o.x = pk2(w.x, w.y); o.y = pk2(w.z, w.w);
                    *(u32x2*)(hb0 + (size_t)row * D + 4 * lane + 256 * j) = o;
                }
                s = wave_sum(s);
                if (lane < 16) ssq[(size_t)lane * T + row] = lane == 0 ? s : 0.f;
                }
            }
        }
    }
}

DEVI void phase_layer_pre(const Params& P, int wv, int vc, unsigned char* lds, int layer) {
    const int tid = opaque_tid(), lane = tid & 63, wave = wv;
    const int gw = vc * NWAVES + wave, ngw = gridDim.x * NWAVES;
    float* scr = (float*)(lds + wave * 8704);
    unsigned char* ws = P.ws;
    cv_run(P, layer, gw, ngw, scr, lane);
    const float* p = P.in[I_P] + (size_t)layer * T * PLE; bf16_t* pb = (bf16_t*)(ws + WS_PB);
    {
        const size_t stride = (size_t)gridDim.x * NTHREADS, i0 = (size_t)vc * NTHREADS + tid, nq = (size_t)T * PLE / 4;
        for (size_t base = i0; base < nq; base += 8 * stride) {
            f32x4 v[8];
#pragma unroll
            for (int j = 0; j < 8; ++j) { const size_t idx = base + j * stride; v[j] = idx < nq ? ((const f32x4*)p)[idx] : (f32x4){0.f, 0.f, 0.f, 0.f}; }
#pragma unroll
            for (int j = 0; j < 8; ++j) { const size_t idx = base + j * stride; if (idx < nq) { u32x2 o; o.x = pk2(v[j].x, v[j].y); o.y = pk2(v[j].z, v[j].w); ((u32x2*)pb)[idx] = o; } }
        }
    }
}

struct Unit {
    int pm, pn;
    const bf16_t* A;
    const LAS int* rows;
    int nvalid;
    const bf16_t* B0;
    const bf16_t* B1;
    int aux0, aux1;
    int idx;
};
struct GemmShape { int lda, ldb, K, ksplit; bool gatherA; };
constexpr int NXCD = 8, WGM = 8;
struct PlainSched {
    const bf16_t* A; const bf16_t* Bt; int lda, ldb; int nM, nN, nwg, G, c;
    DEVI void init(const bf16_t* A_, int lda_, const bf16_t* Bt_, int ldb_, int M, int N, int G_, int c_) { A = A_; Bt = Bt_; lda = lda_; ldb = ldb_; nM = M / 256; nN = N / 256; nwg = nM * nN; G = G_; c = c_; }
    DEVI bool next(int i, Unit& u) const {
        const long L = (long)i * G + c; if (L >= nwg) return false;
        int wgid = (int)L; { const int q = nwg / NXCD, r = nwg % NXCD, xcd = wgid % NXCD, off = wgid / NXCD; wgid = (xcd < r ? xcd * (q + 1) : r * (q + 1) + (xcd - r) * q) + off; }
        const int nig = WGM * nN, gid = wgid / nig, fm = gid * WGM, gsz = (nM - fm) < WGM ? (nM - fm) : WGM;
        u.pm = fm + ((wgid % nig) % gsz); u.pn = (wgid % nig) / gsz;
        u.A = A + (size_t)u.pm * 256 * lda; u.rows = nullptr; u.nvalid = 256; u.B0 = Bt + (size_t)u.pn * 256 * ldb; u.B1 = u.B0; u.aux0 = 0; u.aux1 = 0; u.idx = i;
        return true;
    }
};
constexpr int LDS_RTAB = LDS_SCHED + 8192;
struct NoHook { DEVI void operator()() const {} };
template <class Sched> struct RstdHook {
    int wv; unsigned char* lds; const Sched* S; const float* ssq;
    DEVI void operator()() const {
        const int tid = opaque_tid();
        LAS float* rtab = (LAS float*)((LAS unsigned char*)lds + LDS_RTAB);
        const int half = __builtin_amdgcn_readfirstlane(tid >> 8), r = tid & 255;
        float v[2]; bool ok[2];
#pragma unroll
        for (int i2 = 0; i2 < 2; ++i2) { Unit u; ok[i2] = S->next(2 * i2 + half, u); v[i2] = ok[i2] ? rstd16s(ssq, u.pm * 256 + r) : 0.f; }
#pragma unroll
        for (int i2 = 0; i2 < 2; ++i2) if (ok[i2]) rtab[(2 * i2 + half) * 256 + r] = v[i2];
    }
};
template <class Sched> DEVI void rstd_table_setup(int wv, unsigned char* lds, const Sched& S, const float* ssq) {
    const int tid = opaque_tid();
    LAS float* rtab = (LAS float*)((LAS unsigned char*)lds + LDS_RTAB);
    __syncthreads();
    const int half = __builtin_amdgcn_readfirstlane(tid >> 8), r = tid & 255;
    float v[2]; bool ok[2];
#pragma unroll
    for (int i2 = 0; i2 < 2; ++i2) { Unit u; ok[i2] = S.next(2 * i2 + half, u); v[i2] = ok[i2] ? rstd16s(ssq, u.pm * 256 + r) : 0.f; }
#pragma unroll
    for (int i2 = 0; i2 < 2; ++i2) if (ok[i2]) rtab[(2 * i2 + half) * 256 + r] = v[i2];
    __syncthreads();
}
DEVI void cls_experts(int cl, int& e1, int& e2) { const int g = cl / 6, p = cl % 6; const int a = p < 3 ? 0 : (p < 5 ? 1 : 2); const int b = p < 3 ? p + 1 : (p < 5 ? p - 1 : 3); e1 = g * 4 + a; e2 = g * 4 + b; }
DEVI int moe_find_cls(const LAS int* pre, int rt) { int cl = 0;
#pragma unroll 1
    for (int k = 1; k < NCLS; ++k) if (pre[k] <= rt) cl = k;
    return cl; }
struct MoeSched {
    const LAS int* pre; const LAS int* cnt; const LAS int* rowsl; int ncol, G, c; bool up; const bf16_t* A; const bf16_t* W;
    DEVI bool next(int i, Unit& u) const {
        if (i >= 4) return false;
        const LAS int* ud = pre + 1088 + 4 * i;
        const int rt = ud[0]; if (rt < 0) return false;
        const int pn = ud[1], cl = ud[2];
        u.pm = rt; u.pn = pn; u.rows = rowsl + i * 256; u.nvalid = ud[3]; u.idx = i;
        int e1, e2; cls_experts(cl, e1, e2);
        if (up) { const int which = pn >> 2; const int e = which ? e2 : e1; u.A = A; u.B0 = W + ((size_t)e * 1024 + (pn & 3) * 256) * 1024; u.B1 = u.B0; u.aux0 = rt * 256; u.aux1 = which; }
        else { u.A = A + (size_t)rt * 256 * 1024; u.B0 = W + ((size_t)e1 * 1024 + pn * 256) * 512; u.B1 = W + ((size_t)e2 * 1024 + pn * 256) * 512; u.aux0 = rt * 256; u.aux1 = 0; }
        return true;
    }
};
enum { MOE_UP_A = 0, MOE_UP_B, MOE_DN_B, MOE_DN_C };
DEVI int moe_sched_setup(const Params& P, int wv, int vc, int layer, LAS int* lds_pre, LAS int* lds_cnt, LAS int* rowsl, int ncol, int mode, bool grp) {
    const int* cnt = (const int*)(P.ws + CTL_CNT) + layer * 32 * CNT_STRIDE; const int* list = (const int*)(P.ws + WS_LIST);
    const int tid = opaque_tid();
    __syncthreads();
    if (mode == MOE_UP_A && tid < 32) {
        const int n = tid < NCLS ? cnt[tid * CNT_STRIDE] : 0; const int tl = (n + 255) >> 8; int x = tl;
#pragma unroll
        for (int o = 1; o < 32; o <<= 1) { const int y = __shfl_up(x, o); if (tid >= o) x += y; }
        if (tid < NCLS) { lds_cnt[tid] = n; lds_pre[tid] = x - tl; }
        if (tid == NCLS - 1) lds_pre[NCLS] = x;
    }
    __syncthreads();
    int ntile = lds_pre[NCLS], G = (int)gridDim.x, c = vc, rt0 = 0;
    if (grp) { const int x = vc & 7, q = ntile >> 3, rem = ntile & 7; G >>= 3; c = vc >> 3; rt0 = x * q + (x < rem ? x : rem); ntile = q + (x < rem ? 1 : 0); }
    const int n2 = 8 * ntile, n3 = 4 * ntile;
    const int nA = n2 < 2 * G ? n2 : 2 * G, nB = n2 - nA;
    const int wB = nB < G ? nB : G;
    const int dB = (G - wB) < n3 ? (G - wB) : n3;
    int L0, N, c_off, Gx;
    if (mode == MOE_UP_A) { L0 = 0; N = nA; c_off = 0; Gx = G; }
    else if (mode == MOE_UP_B) { L0 = nA; N = nB; c_off = 0; Gx = wB > 0 ? wB : 1; }
    else if (mode == MOE_DN_B) { L0 = 0; N = dB; c_off = wB; Gx = (G - wB) > 0 ? (G - wB) : 1; }
    else { L0 = dB; N = n3 - dB; c_off = 0; Gx = G; }
    const int my = c - c_off;
    const int lane = tid & 63;
    const int pre_l = lds_pre[lane < NCLS ? lane : NCLS];
    int cl_[4], tt_[4], nv_[4]; bool ok_[4];
#pragma unroll
    for (int i = 0; i < 4; ++i) {
        const int L = L0 + my + i * Gx;
        ok_[i] = !(my < 0 || my >= Gx || L >= L0 + N);
        const int rt = rt0 + (ok_[i] ? L / ncol : 0);
        const unsigned long long m = __ballot(lane < NCLS && pre_l <= rt);
        const int cl = __popcll(m) - 1;
        const int tt = rt - lds_pre[cl]; int nv = lds_cnt[cl] - 256 * tt; nv = nv < 256 ? nv : 256;
        cl_[i] = cl; tt_[i] = tt; nv_[i] = nv;
        if (tid == 0) { lds_pre[1088 + 4 * i] = ok_[i] ? rt : -1; lds_pre[1089 + 4 * i] = L % ncol; lds_pre[1090 + 4 * i] = cl; lds_pre[1091 + 4 * i] = nv; }
    }
    (void)tt_; (void)list; (void)rowsl;
    __syncthreads();
    return N;
}
struct MoeListHook {
    int wv; const LAS int* pre; const LAS int* cnt_; LAS int* rowsl; const int* list; bool sync;
    DEVI void operator()() const {
        const int tid = opaque_tid(), hsel = __builtin_amdgcn_readfirstlane(tid >> 8), r = tid & 255; int v[2];
#pragma unroll
        for (int i2 = 0; i2 < 2; ++i2) {
            const LAS int* ud = pre + 1088 + 4 * (2 * i2 + hsel);
            const int rt = ud[0], cl = ud[2], nv = ud[3]; const bool ok = rt >= 0;
            const int tt = rt - pre[ok ? cl : 0];
            v[i2] = ok ? list[(size_t)cl * T + 256 * tt + (r < nv ? r : nv - 1)] : 0;
        }
#pragma unroll
        for (int i2 = 0; i2 < 2; ++i2) rowsl[(2 * i2 + hsel) * 256 + r] = v[i2];
        if (sync) __syncthreads();
    }
};

DEVI int perm32(int rho) { const int n = rho >> 4, i = rho & 15; return 8 * (i >> 2) + 4 * n + (i & 3); }
DEVI int unit_row(const Unit& u, int r) { return u.rows ? u.rows[r] : u.pm * 256 + r; }
DEVI bool unit_valid(const Unit& u, int r) { return !u.rows || r < u.nvalid; }

typedef __bf16 bf16x2_t __attribute__((ext_vector_type(2)));
DEVI unsigned pk4_fp8(float a, float b, float c, float d) {
    a = __builtin_amdgcn_fmed3f(a, -224.f, 224.f); b = __builtin_amdgcn_fmed3f(b, -224.f, 224.f); c = __builtin_amdgcn_fmed3f(c, -224.f, 224.f); d = __builtin_amdgcn_fmed3f(d, -224.f, 224.f);
    int w = 0; w = __builtin_amdgcn_cvt_pk_fp8_f32(a, b, w, false); w = __builtin_amdgcn_cvt_pk_fp8_f32(c, d, w, true); return (unsigned)w;
}
DEVI f32x2 fp8lo2(unsigned w) { return __builtin_amdgcn_cvt_pk_f32_fp8((int)w, false); }
DEVI f32x2 fp8hi2(unsigned w) { return __builtin_amdgcn_cvt_pk_f32_fp8((int)w, true); }
DEVI unsigned cvt_pk_bf16(float lo, float hi) { const bf16x2_t v = __builtin_convertvector((f32x2){lo, hi}, bf16x2_t); return __builtin_bit_cast(unsigned, v); }

DEVI f32x2 gelu_tanh2(f32x2 x) {
    const f32x2 x2 = x * x;
    const f32x2 t = x * (x2 * (-2.0f * 1.4426950408889634f * 0.7978845608028654f * 0.044715f) + (-2.0f * 1.4426950408889634f * 0.7978845608028654f));
    f32x2 e; e.x = __builtin_amdgcn_exp2f(t.x); e.y = __builtin_amdgcn_exp2f(t.y);
    const f32x2 d = e + 1.0f;
    f32x2 r; r.x = __builtin_amdgcn_rcpf(d.x); r.y = __builtin_amdgcn_rcpf(d.y);
    return x * r;
}
DEVI f32x2 sigmoid2(f32x2 x) {
    const f32x2 t = x * (-1.4426950408889634f);
    f32x2 e; e.x = __builtin_amdgcn_exp2f(t.x); e.y = __builtin_amdgcn_exp2f(t.y);
    const f32x2 d = e + 1.0f;
    f32x2 r; r.x = __builtin_amdgcn_rcpf(d.x); r.y = __builtin_amdgcn_rcpf(d.y);
    return r;
}
DEVI u32x4 xchg8(u32x4 v) { u32x4 r; r.x = __shfl_xor(v.x, 8); r.y = __shfl_xor(v.y, 8); r.z = __shfl_xor(v.z, 8); r.w = __shfl_xor(v.w, 8); return r; }
DEVI u32x4 sel4(bool c, u32x4 a, u32x4 b) { u32x4 r; r.x = c ? a.x : b.x; r.y = c ? a.y : b.y; r.z = c ? a.z : b.z; r.w = c ? a.w : b.w; return r; }
template <bool F8>
struct EpiZT {
    static constexpr bool PERM = true, CMAP = true;
    bf16_t* O; int ldc; const LAS float* ssq; int act; float* lnstat; int stat_pn0;
    DEVI void operator()(const f32x4 (&acc)[2][2][4][2], const Unit& u, int wr, int wc, int fr, int fq) const {
        const bool st = act == 1 && u.pn >= stat_pn0;
        const bool lo = fr < 8;
        const int colx = u.pn * 256 + 64 * wc + (lo ? 0 : 32) + 8 * fq;
#pragma unroll
        for (int ai = 0; ai < 2; ++ai)
#pragma unroll
            for (int m = 0; m < 4; ++m) {
                const int rloc = ai * 128 + wr * 64 + m * 16;
                const int row = u.pm * 256 + rloc + fr;
                const float rs = ssq ? ssq[u.idx * 256 + rloc + fr] : 1.0f;
                f32x2 sv1 = (f32x2){0.f, 0.f}, sv2 = (f32x2){0.f, 0.f};
                u32x4 Pz[2]; f32x2 Pf[2][4];
#pragma unroll
                for (int bj = 0; bj < 2; ++bj) {
                    f32x2 v2[4];
#pragma unroll
                    for (int n = 0; n < 2; ++n)
#pragma unroll
                        for (int e = 0; e < 2; ++e) {
                            f32x2 x = (f32x2){acc[ai][bj][m][n][2 * e], acc[ai][bj][m][n][2 * e + 1]} * rs;
                            if (st) x = gelu_tanh2(x);
                            v2[2 * n + e] = x; if (st) { sv1 += x; sv2 += x * x; }
                        }
                    Pz[bj].x = cvt_pk_bf16(v2[0].x, v2[0].y); Pz[bj].y = cvt_pk_bf16(v2[1].x, v2[1].y); Pz[bj].z = cvt_pk_bf16(v2[2].x, v2[2].y); Pz[bj].w = cvt_pk_bf16(v2[3].x, v2[3].y);
#pragma unroll
                    for (int q4 = 0; q4 < 4; ++q4) Pf[bj][q4] = v2[q4];
                }
                if (F8) {
                    u32x2 P8[2];
#pragma unroll
                    for (int bj = 0; bj < 2; ++bj) { P8[bj].x = pk4_fp8(Pf[bj][0].x, Pf[bj][0].y, Pf[bj][1].x, Pf[bj][1].y); P8[bj].y = pk4_fp8(Pf[bj][2].x, Pf[bj][2].y, Pf[bj][3].x, Pf[bj][3].y); }
                    const bool ev = (fq & 1) == 0;
                    const u32x2 snd = ev ? P8[1] : P8[0];
                    u32x2 rc; rc.x = __shfl_xor(snd.x, 16); rc.y = __shfl_xor(snd.y, 16);
                    const u32x4 o16 = ev ? (u32x4){P8[0].x, P8[0].y, rc.x, rc.y} : (u32x4){rc.x, rc.y, P8[1].x, P8[1].y};
                    const int col8 = u.pn * 256 + 64 * wc + (ev ? 0 : 32) + 16 * (fq >> 1);
                    *(u32x4*)((unsigned char*)O + (size_t)row * ldc + col8) = o16;
                } else {
                const u32x4 rcv = xchg8(sel4(lo, Pz[1], Pz[0]));
                const size_t rowA = (size_t)(u.pm * 256 + rloc + (fr & 7));
                *(u32x4*)(O + rowA * ldc + colx) = sel4(lo, Pz[0], rcv);
                *(u32x4*)(O + (rowA + 8) * ldc + colx) = sel4(lo, rcv, Pz[1]);
                }
                if (st) {
                    float s1 = sv1.x + sv1.y, s2 = sv2.x + sv2.y;
                    s1 += __shfl_xor(s1, 16); s1 += __shfl_xor(s1, 32); s2 += __shfl_xor(s2, 16); s2 += __shfl_xor(s2, 32);
                    if (fq == 0) *(f32x2*)(lnstat + ((size_t)row * 32 + (u.pn - stat_pn0) * 4 + wc) * 2) = (f32x2){s1, s2};
                }
            }
    }
};
typedef EpiZT<false> EpiZ;
struct EpiAct {
    static constexpr bool PERM = true, CMAP = false;
    bf16_t* act; const f32x4* tokinfo;
    DEVI void operator()(const f32x4 (&acc)[2][2][4][2], const Unit& u, int wr, int wc, int fr, int fq) const {
        f32x4 infos[8];
#pragma unroll
        for (int it = 0; it < 8; ++it) infos[it] = tokinfo[unit_row(u, (it >> 2) * 128 + wr * 64 + (it & 3) * 16 + fr)];
#pragma unroll
        for (int ai = 0; ai < 2; ++ai)
#pragma unroll
            for (int m = 0; m < 4; ++m) {
                const int r = ai * 128 + wr * 64 + m * 16 + fr;
                const f32x4 info = infos[ai * 4 + m];
                const float rs = info.x, w = u.aux1 ? info.z : info.y;
                f32x2 v2[4]; const float rsw = rs * w;
#pragma unroll
                for (int n = 0; n < 2; ++n)
#pragma unroll
                    for (int e = 0; e < 2; ++e) {
                        const f32x2 g = (f32x2){acc[ai][0][m][n][2 * e], acc[ai][0][m][n][2 * e + 1]} * rs, up = (f32x2){acc[ai][1][m][n][2 * e], acc[ai][1][m][n][2 * e + 1]} * rsw;
                        v2[2 * n + e] = g * sigmoid2(g) * up;
                    }
                u32x4 o; o.x = cvt_pk_bf16(v2[0].x, v2[0].y); o.y = cvt_pk_bf16(v2[1].x, v2[1].y); o.z = cvt_pk_bf16(v2[2].x, v2[2].y); o.w = cvt_pk_bf16(v2[3].x, v2[3].y);
                *(u32x4*)(act + (size_t)(u.aux0 + r) * 1024 + u.aux1 * 512 + (u.pn & 3) * 128 + wc * 32 + 8 * fq) = o;
            }
    }
};
template <bool UP>
struct EpiRes {
    static constexpr bool PERM = true, CMAP = true;
    static constexpr int NB = UP ? 2 : 4;
    const bf16_t* hin; bf16_t* hout; float* ssq_out; const bf16_t* uple; const LAS float* ssq_in;
    DEVI void operator()(const f32x4 (&acc)[2][2][4][2], const Unit& u, int wr, int wc, int fr, int fq) const {
        asm volatile("" : "+v"(fr), "+v"(fq));
        const bool lo = fr < 8;
        const int colx = u.pn * 256 + 64 * wc + (lo ? 0 : 32) + 8 * fq;
        u32x4 hb[NB][2], ub[UP ? NB : 1][2];
#pragma unroll
        for (int it = 0; it < NB; ++it) {
            const int rA = (it >> 2) * 128 + wr * 64 + (it & 3) * 16 + (fr & 7);
            const size_t offA = (size_t)unit_row(u, rA) * D + colx, offB = (size_t)unit_row(u, rA + 8) * D + colx;
            hb[it][0] = *(const u32x4*)(hin + offA); hb[it][1] = *(const u32x4*)(hin + offB);
            if (UP) { ub[it][0] = *(const u32x4*)(uple + offA); ub[it][1] = *(const u32x4*)(uple + offB); }
        }
#pragma unroll
        for (int it = 0; it < 8; ++it) {
            const int ai = it >> 2, m = it & 3, sl = it % NB;
            const int rloc = ai * 128 + wr * 64 + m * 16, r = rloc + fr, rA = rloc + (fr & 7), rB = rA + 8;
            const size_t offA = (size_t)unit_row(u, rA) * D + colx, offB = (size_t)unit_row(u, rB) * D + colx;
            const bool okA = unit_valid(u, rA), okB = unit_valid(u, rB);
            const u32x4 hr = xchg8(sel4(lo, hb[sl][1], hb[sl][0]));
            const u32x4 hme[2] = {sel4(lo, hb[sl][0], hr), sel4(lo, hr, hb[sl][1])};
            u32x4 ume[2];
            if (UP) { const u32x4 ur = xchg8(sel4(lo, ub[sl][1], ub[sl][0])); ume[0] = sel4(lo, ub[sl][0], ur); ume[1] = sel4(lo, ur, ub[sl][1]); }
            if (it + NB < 8) {
                const int rN = ((it + NB) >> 2) * 128 + wr * 64 + ((it + NB) & 3) * 16 + (fr & 7);
                const size_t onA = (size_t)unit_row(u, rN) * D + colx, onB = (size_t)unit_row(u, rN + 8) * D + colx;
                hb[sl][0] = *(const u32x4*)(hin + onA); hb[sl][1] = *(const u32x4*)(hin + onB);
                if (UP) { ub[sl][0] = *(const u32x4*)(uple + onA); ub[sl][1] = *(const u32x4*)(uple + onB); }
            }
            const float rs = UP ? ssq_in[u.idx * 256 + r] : 1.0f;
            float s2 = 0.f; u32x4 Po[2];
#pragma unroll
            for (int bj = 0; bj < 2; ++bj) {
                float a[8];
#pragma unroll
                for (int n = 0; n < 2; ++n)
#pragma unroll
                    for (int e = 0; e < 4; ++e) a[4 * n + e] = acc[ai][bj][m][n][e];
                if (UP) {
                    const unsigned ua[4] = {ume[bj].x, ume[bj].y, ume[bj].z, ume[bj].w};
#pragma unroll
                    for (int j = 0; j < 4; ++j) { const f32x2 sg = sigmoid2((f32x2){a[2 * j], a[2 * j + 1]} * rs); a[2 * j] = bflo(ua[j]) * sg.x; a[2 * j + 1] = bfhi(ua[j]) * sg.y; }
                }
                const unsigned ha[4] = {hme[bj].x, hme[bj].y, hme[bj].z, hme[bj].w}; unsigned o[4];
#pragma unroll
                for (int j = 0; j < 4; ++j) { o[j] = cvt_pk_bf16(bflo(ha[j]) + a[2 * j], bfhi(ha[j]) + a[2 * j + 1]); const float o0 = bflo(o[j]), o1 = bfhi(o[j]); s2 += o0 * o0 + o1 * o1; }
                Po[bj] = (u32x4){o[0], o[1], o[2], o[3]};
            }
            const u32x4 orv = xchg8(sel4(lo, Po[1], Po[0]));
            if (okA) *(u32x4*)(hout + offA) = sel4(lo, Po[0], orv);
            if (okB) *(u32x4*)(hout + offB) = sel4(lo, orv, Po[1]);
            if (ssq_out) { s2 += __shfl_xor(s2, 16); s2 += __shfl_xor(s2, 32); if (fq == 0 && unit_valid(u, r)) ssq_out[(size_t)(u.pn * 4 + wc) * T + unit_row(u, r)] = s2; }
        }
    }
};

template <class Epi, class Sched>
DEVI void gemm_simple(int wv, const GemmShape g, const Sched& S, const Epi& E) {
    const int tid = opaque_tid(), wid = tid >> 6, lane = tid & 63, wr = wid >> 2, wc = wid & 3, fr = lane & 15, fq = lane >> 4;
    Unit u;
    for (int i = 0; S.next(i, u); ++i) {
        f32x4 acc[2][2][4][2];
#pragma unroll
        for (int a = 0; a < 2; ++a)
#pragma unroll
            for (int b = 0; b < 2; ++b)
#pragma unroll
                for (int m = 0; m < 4; ++m)
#pragma unroll
                    for (int n = 0; n < 2; ++n) acc[a][b][m][n] = (f32x4){0.f, 0.f, 0.f, 0.f};
        const bf16_t* ap[2][4];
#pragma unroll
        for (int ai = 0; ai < 2; ++ai)
#pragma unroll
            for (int m = 0; m < 4; ++m) {
                const int r = ai * 128 + wr * 64 + m * 16 + fr;
                const size_t grow = g.gatherA ? (size_t)u.rows[r] : (size_t)r;
                ap[ai][m] = u.A + grow * g.lda + 8 * fq;
            }
        size_t boff[2][2];
#pragma unroll
        for (int bj = 0; bj < 2; ++bj)
#pragma unroll
            for (int n = 0; n < 2; ++n) {
                const int c = Epi::CMAP ? (64 * wc + 32 * bj + perm32(16 * n + fr)) : (bj * 128 + wc * 32 + (Epi::PERM ? perm32(16 * n + fr) : 16 * n + fr));
                boff[bj][n] = (size_t)c * g.ldb + 8 * fq;
            }
        for (int k0 = 0; k0 < g.K; k0 += 32) {
            const bf16_t* bb = k0 < g.ksplit ? u.B0 + k0 : u.B1 + (k0 - g.ksplit);
            bf16x8 Af[2][4], Bf[2][2];
#pragma unroll
            for (int ai = 0; ai < 2; ++ai)
#pragma unroll
                for (int m = 0; m < 4; ++m) Af[ai][m] = *(const bf16x8*)(ap[ai][m] + k0);
#pragma unroll
            for (int bj = 0; bj < 2; ++bj)
#pragma unroll
                for (int n = 0; n < 2; ++n) Bf[bj][n] = *(const bf16x8*)(bb + boff[bj][n]);
#pragma unroll
            for (int ai = 0; ai < 2; ++ai)
#pragma unroll
                for (int bj = 0; bj < 2; ++bj)
#pragma unroll
                    for (int m = 0; m < 4; ++m)
#pragma unroll
                        for (int n = 0; n < 2; ++n) acc[ai][bj][m][n] = __builtin_amdgcn_mfma_f32_16x16x32_bf16(Bf[bj][n], Af[ai][m], acc[ai][bj][m][n], 0, 0, 0);
        }
        E(acc, u, wr, wc, fr, fq);
    }
}

constexpr int HTB = 128 * 64 * 2;
DEVI int lds_byte(int r, int c) { const int st = (r >> 4) * 2 + (c >> 5), rr = r & 15, cc = c & 31, ob = rr * 64 + cc * 2; return st * 1024 + (ob ^ (((ob >> 9) & 1) << 5)); }
DEVI void stage_rc(int b, int& R, int& C) { const int st = b / 1024, sb = b % 1024, swz = sb ^ (((sb >> 9) & 1) << 5); R = (st >> 1) * 16 + swz / 64; C = (st & 1) * 32 + (swz % 64) / 2; }
template <bool GATHER, class Epi, class Sched, class Hook, class PreA>
DEVI void gemm_fast(int wv, LAS unsigned char* lds, const GemmShape g, const Sched& S, const Epi& E, const Hook& hook, const PreA& prea) {
    const int tid = opaque_tid(), wid = __builtin_amdgcn_readfirstlane(tid >> 6), lane = tid & 63, wr = wid >> 2, wc = wid & 3, fr = lane & 15, fq = lane >> 4;
    const int nt = g.K / 64;
    int sR[2], sC[2]; unsigned voffB[2];
#pragma unroll
    for (int i = 0; i < 2; ++i) { stage_rc(tid * 16 + i * 8192, sR[i], sC[i]); const int Rb = Epi::CMAP ? (64 * (sR[i] >> 5) + perm32(sR[i] & 31)) : (Epi::PERM ? ((sR[i] & ~31) + perm32(sR[i] & 31)) : sR[i]); voffB[i] = (unsigned)(Rb * g.ldb + sC[i]) * 2u; }
    const size_t hstepB = (size_t)(Epi::CMAP ? 32 : 128) * g.ldb * 2;
    const unsigned ldsw = (unsigned)wid * 1024u;
    const int aoff = lds_byte(wr * 64 + fr, fq * 8), boff = lds_byte(wc * 32 + fr, fq * 8);
#define GF_SA(b, h) (((b) * 2 + (h)) * HTB)
#define GF_SB(b, h) ((4 + (b) * 2 + (h)) * HTB)
#define GF_STG(bufoff, base, v0, v1) do { \
        __builtin_amdgcn_global_load_lds((const unsigned*)((base) + (v0)), (LAS unsigned*)(lds + (bufoff) + ldsw), 16, 0, 0); \
        __builtin_amdgcn_global_load_lds((const unsigned*)((base) + (v1)), (LAS unsigned*)(lds + (bufoff) + ldsw + 8192), 16, 0, 0); } while (0)
#define GF_LDA(dst, b, h) do { _Pragma("unroll") for (int m = 0; m < 4; ++m) _Pragma("unroll") for (int k = 0; k < 2; ++k) dst[m][k] = *(const LAS bf16x8*)(lds + GF_SA(b, h) + aoff + m * 2048 + k * 1024); } while (0)
#define GF_LDB(dst, b, h) do { _Pragma("unroll") for (int n = 0; n < 2; ++n) _Pragma("unroll") for (int k = 0; k < 2; ++k) dst[n][k] = *(const LAS bf16x8*)(lds + GF_SB(b, h) + boff + n * 2048 + k * 1024); } while (0)
#define GF_MMA(ai, bj, At, Bt) do { __builtin_amdgcn_s_setprio(1); _Pragma("unroll") for (int m = 0; m < 4; ++m) _Pragma("unroll") for (int n = 0; n < 2; ++n) _Pragma("unroll") for (int k = 0; k < 2; ++k) \
        acc[ai][bj][m][n] = __builtin_amdgcn_mfma_f32_16x16x32_bf16(Bt[n][k], At[m][k], acc[ai][bj][m][n], 0, 0, 0); __builtin_amdgcn_s_setprio(0); } while (0)
#define GF_WAIT_V(n) asm volatile("s_waitcnt vmcnt(" #n ")" ::: "memory")
#define GF_WAIT_L(n) asm volatile("s_waitcnt lgkmcnt(" #n ")" ::: "memory")
#define GF_BAR __builtin_amdgcn_s_barrier()
#define GF_SCHED __builtin_amdgcn_sched_barrier(0)
#define GF_APTR(u, kt) ((const char*)(u).A + (size_t)(kt) * 128)
#define GF_BPTR(u, kt) ((const char*)(((kt) * 64 < g.ksplit) ? (u).B0 + (kt) * 64 : (u).B1 + ((kt) * 64 - g.ksplit)))
#define GF_OFFA(dst, u) do { _Pragma("unroll") for (int h = 0; h < 2; ++h) _Pragma("unroll") for (int i = 0; i < 2; ++i) { const int row_ = h * 128 + sR[i]; \
        const unsigned grow_ = GATHER ? (unsigned)(u).rows[row_] : (unsigned)row_; dst[h][i] = (grow_ * (unsigned)g.lda + (unsigned)sC[i]) * 2u; } } while (0)
    __syncthreads();
    Unit cur, nxt; int ui = 0;
    if (!S.next(0, cur)) return;
    unsigned offA[2][2];
    if (!GATHER) GF_OFFA(offA, cur);
    f32x4 acc[2][2][4][2];
#pragma unroll
    for (int a = 0; a < 2; ++a)
#pragma unroll
        for (int b = 0; b < 2; ++b)
#pragma unroll
            for (int m = 0; m < 4; ++m)
#pragma unroll
                for (int n = 0; n < 2; ++n) acc[a][b][m][n] = (f32x4){0.f, 0.f, 0.f, 0.f};
    bf16x8 At[4][2], B0[2][2], B1[2][2];
    {
        const char* a0 = GF_APTR(cur, 0); const char* b0 = GF_BPTR(cur, 0); const char* a1 = GF_APTR(cur, 1); const char* b1 = GF_BPTR(cur, 1);
        GF_WAIT_L(0);
        GF_STG(GF_SB(0, 0), b0, voffB[0], voffB[1]); GF_STG(GF_SB(0, 1), b0 + hstepB, voffB[0], voffB[1]);
        if (GATHER) { prea(); GF_OFFA(offA, cur); GF_WAIT_L(0); }
        GF_STG(GF_SA(0, 0), a0, offA[0][0], offA[0][1]); GF_STG(GF_SA(0, 1), a0, offA[1][0], offA[1][1]);
        hook();
        if (wr == 1) GF_BAR;
        GF_WAIT_V(2); GF_BAR;
        GF_STG(GF_SB(1, 0), b1, voffB[0], voffB[1]); GF_STG(GF_SA(1, 0), a1, offA[0][0], offA[0][1]); GF_STG(GF_SB(1, 1), b1 + hstepB, voffB[0], voffB[1]);
        GF_WAIT_V(6); GF_BAR;
    }
    for (;;) {
        const bool has_next = S.next(ui + 1, nxt);
#pragma unroll 1
        for (int t = 0; t < nt; t += 2) {
            const bool last = (t == nt - 2), useN = last && has_next;
            const int kt2 = last ? 0 : t + 2;
            const char* a1 = GF_APTR(cur, t + 1);
            const char* a2 = useN ? GF_APTR(nxt, kt2) : GF_APTR(cur, kt2); const char* a3 = a2 + 128;
            const char* b2 = useN ? GF_BPTR(nxt, kt2) : GF_BPTR(cur, kt2);
            const char* b3 = useN ? GF_BPTR(nxt, kt2 + 1) : GF_BPTR(cur, kt2 + 1);
            GF_LDB(B0, 0, 0); GF_LDB(B1, 0, 1); GF_SCHED; GF_LDA(At, 0, 0); GF_STG(GF_SA(1, 1), a1, offA[1][0], offA[1][1]);
            if (GATHER && useN) { GF_OFFA(offA, nxt); }
            GF_WAIT_V(8); GF_WAIT_L(0); GF_BAR; GF_MMA(0, 0, At, B0); GF_MMA(0, 1, At, B1); GF_BAR; GF_SCHED;
            GF_LDA(At, 0, 1); GF_STG(GF_SB(0, 0), b2, voffB[0], voffB[1]); GF_STG(GF_SB(0, 1), b2 + hstepB, voffB[0], voffB[1]); GF_STG(GF_SA(0, 0), a2, offA[0][0], offA[0][1]);
            GF_WAIT_V(8); GF_WAIT_L(0); GF_BAR; GF_MMA(1, 0, At, B0); GF_MMA(1, 1, At, B1); GF_BAR; GF_SCHED;
            GF_LDB(B0, 1, 0); GF_LDB(B1, 1, 1); GF_SCHED; GF_LDA(At, 1, 0); GF_STG(GF_SA(0, 1), a2, offA[1][0], offA[1][1]);
            GF_WAIT_V(8); GF_WAIT_L(0); GF_BAR; GF_MMA(0, 0, At, B0); GF_MMA(0, 1, At, B1); GF_BAR; GF_SCHED;
            GF_LDA(At, 1, 1); GF_STG(GF_SB(1, 0), b3, voffB[0], voffB[1]); GF_STG(GF_SB(1, 1), b3 + hstepB, voffB[0], voffB[1]); GF_STG(GF_SA(1, 0), a3, offA[0][0], offA[0][1]);
            GF_WAIT_V(8); GF_WAIT_L(0); GF_BAR; GF_MMA(1, 0, At, B0); GF_MMA(1, 1, At, B1); GF_BAR; GF_SCHED;
        }
        if (wr == 0) GF_BAR;
        E(acc, cur, wr, wc, fr, fq);
        if (!has_next) break;
#pragma unroll
        for (int a = 0; a < 2; ++a)
#pragma unroll
            for (int b = 0; b < 2; ++b)
#pragma unroll
                for (int m = 0; m < 4; ++m)
#pragma unroll
                    for (int n = 0; n < 2; ++n) acc[a][b][m][n] = (f32x4){0.f, 0.f, 0.f, 0.f};
        cur = nxt; ++ui;
        if (wr == 1) GF_BAR;
    }
    GF_WAIT_V(0);
    GF_BAR;
#undef GF_SA
#undef GF_SB
#undef GF_STG
#undef GF_LDA
#undef GF_LDB
#undef GF_MMA
#undef GF_WAIT_V
#undef GF_WAIT_L
#undef GF_BAR
#undef GF_SCHED
#undef GF_APTR
#undef GF_BPTR
#undef GF_OFFA
}
template <bool GATHER, class Epi, class Sched, class Hook, class PreA>
DEVI void gemm_run(int wv, unsigned char* lds, const GemmShape g, const Sched& S, const Epi& E, const Hook& hook, const PreA& prea) {
#if USE_FAST
    gemm_fast<GATHER>(wv, (LAS unsigned char*)lds + LDS_STAGE, g, S, E, hook, prea);
#else
    prea(); hook(); __syncthreads(); gemm_simple(wv, g, S, E);
#endif
}
template <bool GATHER, class Epi, class Sched, class Hook>
DEVI void gemm_run(int wv, unsigned char* lds, const GemmShape g, const Sched& S, const Epi& E, const Hook& hook) { gemm_run<GATHER>(wv, lds, g, S, E, hook, NoHook{}); }
template <bool GATHER, class Epi, class Sched>
DEVI void gemm_run(int wv, unsigned char* lds, const GemmShape g, const Sched& S, const Epi& E) { gemm_run<GATHER>(wv, lds, g, S, E, NoHook{}); }

DEVI void phase_aproj(const Params& P, int wv, int vc, unsigned char* lds_, int jl, int layer) {
    const int tid = opaque_tid(), lane = tid & 63, wave = tid >> 6, l15 = lane & 15, lq = lane >> 4;
    LAS unsigned char* Wl = (LAS unsigned char*)lds_;
    LAS float* red = (LAS float*)((LAS unsigned char*)lds_ + 33024);
    const bf16_t* hb0 = (const bf16_t*)(P.ws + WS_HB0);
    const bf16_t* wa = (const bf16_t*)(P.ws + WS_GLA_IN) + ((size_t)jl * GLA_IN + GLA_Z) * D;
    const float* ssq = (const float*)(P.ws + WS_SSQP) + (size_t)(layer * 2 + 0) * T * 16;
    float* a = (float*)(P.ws + WS_AGATE);
    const int astep = (int)(gridDim.x >> 3), mt = wave & 3, kh = wave >> 2;
    bf16x8 av[16]; float rsv = 0.f;
    if ((vc >> 3) < 32) {
        const int row = ((vc & 7) * 32 + (vc >> 3)) * 64 + 16 * mt + l15;
        const bf16_t* ap = hb0 + (size_t)row * D + kh * 512 + 8 * lq;
#pragma unroll
        for (int ks = 0; ks < 16; ++ks) av[ks] = *(const bf16x8*)(ap + 32 * ks);
        rsv = rstd16s(ssq, row);
    }
    __syncthreads();
    {
        u32x4 wv4[4];
#pragma unroll
        for (int i = 0; i < 4; ++i) wv4[i] = ((const u32x4*)wa)[tid + NTHREADS * i];
#pragma unroll
        for (int i = 0; i < 4; ++i) { const int q = tid + NTHREADS * i; *(LAS u32x4*)(Wl + (q >> 7) * 2064 + (q & 127) * 16) = wv4[i]; }
    }
    __syncthreads();
    for (int bi_ = vc >> 3; bi_ < 32; bi_ += astep) {
        const int blk = (vc & 7) * 32 + bi_;
        const int row = blk * 64 + 16 * mt + l15;
        f32x4 acc = (f32x4){0.f, 0.f, 0.f, 0.f};
        const LAS unsigned char* bp = Wl + l15 * 2064 + (kh * 512 + 8 * lq) * 2;
        bf16x8 ac[16]; const float rsc = rsv;
#pragma unroll
        for (int ks = 0; ks < 16; ++ks) ac[ks] = av[ks];
        if (bi_ + astep < 32) {
            const int rown = row + astep * 64;
            const bf16_t* ap = hb0 + (size_t)rown * D + kh * 512 + 8 * lq;
#pragma unroll
            for (int ks = 0; ks < 16; ++ks) av[ks] = *(const bf16x8*)(ap + 32 * ks);
            rsv = rstd16s(ssq, rown);
        }
#pragma unroll
        for (int ks = 0; ks < 16; ++ks) acc = __builtin_amdgcn_mfma_f32_16x16x32_bf16(*(const LAS bf16x8*)(bp + 64 * ks), ac[ks], acc, 0, 0, 0);
        __syncthreads();
        if (kh == 1) *(LAS f32x4*)(red + (mt * 64 + lane) * 4) = acc;
        __syncthreads();
        if (kh == 0) {
            const f32x4 o = (acc + *(const LAS f32x4*)(red + (mt * 64 + lane) * 4)) * rsc;
            *(f32x4*)(a + (size_t)row * 16 + 4 * lq) = o;
        }
    }
}
DEVI void phase_g2_simple(const Params& P, int wv, int vc, unsigned char* lds, int jl) {
    const int tid = opaque_tid();
    float* bc = (float*)lds;
    float* ke = (float*)(lds + 32768);
    float* qs = (float*)(lds + 65536);
    float* al = (float*)(lds + 67584);
    float* vl = (float*)(lds + 71680);
    bf16_t* zq = (bf16_t*)(P.ws + WS_ZBUF);
    bf16_t* ST = (bf16_t*)(P.ws + WS_BUF2);
    float* bend = (float*)(P.ws + WS_BEND);
    const float* ag = (const float*)(P.ws + WS_AGATE);
    const float* wgu = P.in[I_GLA_WGU] + (size_t)jl * 16 * 512;
    const float* bg = P.in[I_GLA_BG] + jl * 512;
    for (int ui_ = vc >> 3; ui_ < 128; ui_ += (int)(gridDim.x >> 3)) {
        const int u = (vc & 7) * 128 + ui_;
        const int h = u & 3, n = (u >> 2) & 31, b = u >> 7;
        const int t0 = b * SEQ + n * GCH;
        for (int e = tid; e < 64 * 16; e += NTHREADS) al[e] = ag[(size_t)t0 * 16 + e];
        __syncthreads();
        {
            const int kk = tid & 127, tq = tid >> 7, hk = h * HK + kk;
            float wcol[16];
#pragma unroll
            for (int j = 0; j < 16; ++j) wcol[j] = wgu[j * 512 + hk];
            const float bias = bg[hk];
            float run = 0.f;
            for (int tt = 0; tt < 16; ++tt) {
                const int t = tq * 16 + tt; float x = bias;
#pragma unroll
                for (int j = 0; j < 16; ++j) x += al[t * 16 + j] * wcol[j];
                run += logsigmoidf_(x) * (1.0f / 16.0f);
                bc[t * 128 + kk] = run;
            }
            qs[tq * 128 + kk] = run;
            __syncthreads();
            float pre = 0.f;
            for (int q = 0; q < tq; ++q) pre += qs[q * 128 + kk];
            for (int tt = 0; tt < 16; ++tt) bc[(tq * 16 + tt) * 128 + kk] += pre;
        }
        __syncthreads();
        for (int e = tid; e < 64 * 128; e += NTHREADS) {
            const int t = e >> 7, kk = e & 127;
            const float bcv = bc[t * 128 + kk], be = bc[63 * 128 + kk];
            const size_t qoff = (size_t)(t0 + t) * GLA_Z + h * HK + kk;
            const float qv = bf2f(zq[qoff]), kv = bf2f(zq[qoff + 512]);
            zq[qoff] = (bf16_t)f2bf(qv * 0.08838834764831845f * __expf(bcv));
            zq[qoff + 512] = (bf16_t)f2bf(kv * __expf(-bcv));
            ke[t * 128 + kk] = bf2f(f2bf(kv * __expf(be - bcv)));
        }
        for (int e = tid; e < 64 * 256; e += NTHREADS) { const int t = e >> 8, vv = e & 255; vl[e] = bf2f(zq[(size_t)(t0 + t) * GLA_Z + 1024 + h * HV + vv]); }
        if (tid < 128) bend[u * 128 + tid] = bc[63 * 128 + tid];
        __syncthreads();
        {
            const int kk = tid & 127, vg = tid >> 7;
            float kcol[64];
#pragma unroll
            for (int t = 0; t < 64; ++t) kcol[t] = ke[t * 128 + kk];
            for (int vi = 0; vi < 64; ++vi) {
                const int vv = vg * 64 + vi; float s = 0.f;
#pragma unroll
                for (int t = 0; t < 64; ++t) s += kcol[t] * vl[t * 256 + vv];
                ST[(size_t)u * 32768 + vv * 128 + kk] = (bf16_t)f2bf(s);
            }
        }
        __syncthreads();
    }
}
DEVI void phase_g3(const Params& P, int wv, int vc, unsigned char* lds_) {
    const int tid = opaque_tid();
    LAS float* dec = (LAS float*)((LAS unsigned char*)lds_);
    unsigned char* ST = P.ws + WS_BUF2;
    const float* bend = (const float*)(P.ws + WS_BEND);
    for (int wi_ = vc >> 3; wi_ < 32; wi_ += (int)(gridDim.x >> 3)) {
        const int wg = (vc & 7) * 32 + wi_;
        const int vg = wg & 7, h = (wg >> 3) & 3, b = wg >> 5;
        int tl = tid; asm volatile("" : "+v"(tl));
        const int kc = tl & 15, vv = vg * 32 + (tl >> 4);
        __syncthreads();
        u32x2 kv[32];
        unsigned char* base = ST + (size_t)(b * 128 + h) * 32768 + vv * 128 + kc * 8;
#pragma unroll
        for (int n = 0; n < 32; ++n) kv[n] = *(const u32x2*)(base + (size_t)n * 4 * 32768);
#pragma unroll
        for (int i = 0; i < 8; ++i) { const int e = tl + NTHREADS * i; const int n = e >> 7, kk = e & 127; dec[e] = __expf(bend[((b * 32 + n) * 4 + h) * 128 + kk]); }
        __syncthreads();
        float st[8]; float zero = 0.f; asm volatile("" : "+v"(zero));
#pragma unroll
        for (int j = 0; j < 8; ++j) st[j] = zero;
#pragma unroll
        for (int n = 0; n < 32; ++n) {
            u32x2 o; o.x = pk4_fp8(st[0], st[1], st[2], st[3]); o.y = pk4_fp8(st[4], st[5], st[6], st[7]);
            *(u32x2*)(base + (size_t)n * 4 * 32768) = o;
            const f32x4 d0 = *(const LAS f32x4*)(dec + n * 128 + kc * 8), d1 = *(const LAS f32x4*)(dec + n * 128 + kc * 8 + 4);
            const f32x2 k01 = fp8lo2(kv[n].x), k23 = fp8hi2(kv[n].x), k45 = fp8lo2(kv[n].y), k67 = fp8hi2(kv[n].y);
            st[0] = d0.x * st[0] + k01.x; st[1] = d0.y * st[1] + k01.y;
            st[2] = d0.z * st[2] + k23.x; st[3] = d0.w * st[3] + k23.y;
            st[4] = d1.x * st[4] + k45.x; st[5] = d1.y * st[5] + k45.y;
            st[6] = d1.z * st[6] + k67.x; st[7] = d1.w * st[7] + k67.y;
        }
    }
}
DEVI void phase_g4_simple(const Params& P, int wv, int vc, unsigned char* lds, int jl) {
    const int tid = opaque_tid(), lane = tid & 63, wave = tid >> 6;
    float* qd = (float*)lds;
    float* kd = (float*)(lds + 33024);
    float* Pm = (float*)(lds + 66048);
    float* O = (float*)(lds + 82688);
    const bf16_t* zq = (const bf16_t*)(P.ws + WS_ZBUF);
    bf16_t* ob = (bf16_t*)(P.ws + WS_ZBUF + ZB_OB);
    const bf16_t* ST = (const bf16_t*)(P.ws + WS_BUF2);
    const float* gh = P.in[I_GLA_GH] + jl * 1024;
    for (int ui_ = vc >> 3; ui_ < 128; ui_ += (int)(gridDim.x >> 3)) {
        const int u = (vc & 7) * 128 + ui_;
        const int h = u & 3, n = (u >> 2) & 31, b = u >> 7;
        const int t0 = b * SEQ + n * GCH;
        for (int e = tid; e < 64 * 128; e += NTHREADS) {
            const int t = e >> 7, kk = e & 127; const size_t qoff = (size_t)(t0 + t) * GLA_Z + h * HK + kk;
            qd[t * 129 + kk] = bf2f(zq[qoff]); kd[t * 129 + kk] = bf2f(zq[qoff + 512]);
        }
        __syncthreads();
        for (int e = tid; e < 64 * 64; e += NTHREADS) {
            const int i = e >> 6, j = e & 63; float s = 0.f;
            if (j <= i) { for (int kk = 0; kk < 128; ++kk) s += qd[i * 129 + kk] * kd[j * 129 + kk]; }
            Pm[i * 65 + j] = s;
        }
        __syncthreads();
        {
            const int vv = tid & 255, ih = tid >> 8;
#pragma unroll 1
            for (int hf = 0; hf < 2; ++hf) {
                float S[64];
                const u32x4* sp = (const u32x4*)(ST + (size_t)u * 32768 + vv * 128 + hf * 64);
#pragma unroll
                for (int c = 0; c < 8; ++c) { const u32x4 w = sp[c]; S[8 * c + 0] = bflo(w.x); S[8 * c + 1] = bfhi(w.x); S[8 * c + 2] = bflo(w.y); S[8 * c + 3] = bfhi(w.y); S[8 * c + 4] = bflo(w.z); S[8 * c + 5] = bfhi(w.z); S[8 * c + 6] = bflo(w.w); S[8 * c + 7] = bfhi(w.w); }
#pragma unroll 1
                for (int ii = 0; ii < 32; ++ii) {
                    const int i = ih * 32 + ii; float o = hf ? O[i * 256 + vv] : 0.f;
#pragma unroll
                    for (int kk = 0; kk < 64; ++kk) o += qd[i * 129 + hf * 64 + kk] * S[kk];
                    O[i * 256 + vv] = o;
                }
            }
            {
                float V[64];
#pragma unroll
                for (int j = 0; j < 64; ++j) V[j] = bf2f(zq[(size_t)(t0 + j) * GLA_Z + 1024 + h * HV + vv]);
                for (int ii = 0; ii < 32; ++ii) {
                    const int i = ih * 32 + ii; float o = O[i * 256 + vv];
#pragma unroll
                    for (int j = 0; j < 64; ++j) o += Pm[i * 65 + j] * V[j];
                    O[i * 256 + vv] = o;
                }
            }
        }
        __syncthreads();
        for (int ii = 0; ii < 8; ++ii) {
            const int i = wave * 8 + ii;
            float x[4]; float s = 0.f;
#pragma unroll
            for (int q = 0; q < 4; ++q) { x[q] = O[i * 256 + lane + 64 * q]; s += x[q] * x[q]; }
            s = wave_sum(s);
            const float rs = rsqrtf(s * (1.0f / HV) + EPS);
#pragma unroll
            for (int q = 0; q < 4; ++q) {
                const int vv = lane + 64 * q;
                const float r = bf2f(zq[(size_t)(t0 + i) * GLA_Z + 2048 + h * HV + vv]);
                ob[(size_t)(t0 + i) * 1024 + h * HV + vv] = (bf16_t)f2bf(x[q] * rs * gh[h * HV + vv] * siluf_(r));
            }
        }
        __syncthreads();
    }
}

DEVI void phase_s2_simple(const Params& P, int wv, int vc, unsigned char* lds, int jl) {
    const int tid = opaque_tid();
    float* w = (float*)lds;
    float* mu = (float*)(lds + 65536);
    float* rsd = (float*)(lds + 65536 + 512);
    const bf16_t* z = (const bf16_t*)(P.ws + WS_ZBUF);
    bf16_t* ug = (bf16_t*)(P.ws + WS_BUF2);
    const float* lnstat = (const float*)(P.ws + WS_LNP) + (size_t)jl * T * 64;
    const bf16_t* wsb = (const bf16_t*)(P.ws + WS_SGUWS) + (size_t)jl * 8 * 128 * 128;
    const float* lng = P.in[I_SGU_LNG] + jl * SGU_W; const float* lnb = P.in[I_SGU_LNB] + jl * SGU_W;
    const float* bs = P.in[I_SGU_BS] + jl * 8 * 128;
    for (int ui_ = vc >> 3; ui_ < 128; ui_ += (int)(gridDim.x >> 3)) {
        const int u = (vc & 7) * 128 + ui_;
        const int g = u & 7, n = (u >> 3) & 15, b = u >> 7;
        const int t0 = b * SEQ + n * SCH;
        for (int e = tid; e < 128 * 128; e += NTHREADS) w[e] = bf2f(wsb[(size_t)g * 16384 + e]);
        if (tid < 128) {
            float s1 = 0.f, s2 = 0.f; f32x4 sv[16];
#pragma unroll
            for (int q = 0; q < 16; ++q) sv[q] = *(const f32x4*)(lnstat + (size_t)(t0 + tid) * 64 + 4 * q);
#pragma unroll
            for (int q = 0; q < 16; ++q) { s1 += sv[q].x; s2 += sv[q].y; s1 += sv[q].z; s2 += sv[q].w; }
            const float mean = s1 * (1.0f / SGU_W); const float var = fmaxf(s2 * (1.0f / SGU_W) - mean * mean, 0.f);
            mu[tid] = mean; rsd[tid] = rsqrtf(var + EPS);
        }
        __syncthreads();
        {
            const int c = tid & 255, th = tid >> 8, col = g * SGC + c;
            const float gg = lng[col], bb = lnb[col];
            float vn[128];
#pragma unroll
            for (int s = 0; s < 128; ++s) { const float x = bf2f(z[(size_t)(t0 + s) * SGU_Z + SGU_W + col]); vn[s] = (x - mu[s]) * rsd[s] * gg + bb; }
            for (int tt = 0; tt < 64; ++tt) {
                const int t = 2 * tt + th; float s = bs[g * 128 + t];
#pragma unroll
                for (int sp = 0; sp < 128; ++sp) s += w[t * 128 + sp] * vn[sp];
                const float uv = bf2f(z[(size_t)(t0 + t) * SGU_Z + col]);
                ug[(size_t)(t0 + t) * SGU_W + col] = (bf16_t)f2bf(uv * s);
            }
        }
        __syncthreads();
    }
}


typedef short v4i16_t __attribute__((ext_vector_type(4)));
DEVI bf16x8 lds_col8(const LAS unsigned short* p, int ld, int l15) {
    const LAS unsigned short* a = p + ((l15 >> 2) * ld + 4 * (l15 & 3) - l15);
    const v4i16_t lo = __builtin_amdgcn_ds_read_tr16_b64_v4i16((LAS v4i16_t*)a), hi = __builtin_amdgcn_ds_read_tr16_b64_v4i16((LAS v4i16_t*)(a + 4 * ld));
    bf16x8 r; r[0] = lo[0]; r[1] = lo[1]; r[2] = lo[2]; r[3] = lo[3]; r[4] = hi[0]; r[5] = hi[1]; r[6] = hi[2]; r[7] = hi[3];
    return r;
}
DEVI f32x4 mfma16(bf16x8 a, bf16x8 b, f32x4 c) { return __builtin_amdgcn_mfma_f32_16x16x32_bf16(a, b, c, 0, 0, 0); }

struct G2Pre { float al[2]; u32x4 vw[4], qw[2], kw[2]; };
DEVI void g2_load(G2Pre& p, const bf16_t* zq, const float* ag, int u, int tid) {
    const int h = u & 3, n = (u >> 2) & 31, b = u >> 7, t0 = b * SEQ + n * GCH;
#pragma unroll
    for (int i = 0; i < 2; ++i) p.al[i] = ag[(size_t)t0 * 16 + tid + NTHREADS * i];
#pragma unroll
    for (int i = 0; i < 4; ++i) {
        const int c = tid + NTHREADS * i, row = c >> 5, cc = c & 31;
        p.vw[i] = *(const u32x4*)(zq + (size_t)(t0 + row) * GLA_Z + 1024 + h * HV + 8 * cc);
    }
#pragma unroll
    for (int i = 0; i < 2; ++i) {
        const int c = tid + NTHREADS * i, t = c >> 4, cc = c & 15;
        const size_t qoff = (size_t)(t0 + t) * GLA_Z + h * HK + 8 * cc;
        p.qw[i] = *(const u32x4*)(zq + qoff); p.kw[i] = *(const u32x4*)(zq + qoff + 512);
    }
}
template <bool HAS_NEXT>
DEVI void g2_unit(G2Pre& nx, bf16_t* zq, unsigned char* ST, float* bend, const float* ag, const float (&wcol)[16], float bias, LAS unsigned char* lds, int u, int u_next,
                  int tid, int wave, int l15, int lq) {
    LAS float* bc = (LAS float*)lds;
    LAS float* al = (LAS float*)(lds + 33024);
    LAS float* qs = (LAS float*)(lds + 37120);
    LAS unsigned short* Ke = (LAS unsigned short*)(lds + 39168);
    LAS unsigned short* V = (LAS unsigned short*)(lds + 56064);
    const int h = u & 3, n = (u >> 2) & 31, b = u >> 7;
    const int t0 = b * SEQ + n * GCH;
    __syncthreads();
#pragma unroll
    for (int i = 0; i < 2; ++i) al[tid + NTHREADS * i] = nx.al[i];
#pragma unroll
    for (int i = 0; i < 4; ++i) {
        const int c = tid + NTHREADS * i, row = c >> 5, cc = c & 31;
        const u32x4 w = nx.vw[i];
        *(LAS u32x2*)(V + row * 260 + cc * 8) = (u32x2){w.x, w.y}; *(LAS u32x2*)(V + row * 260 + cc * 8 + 4) = (u32x2){w.z, w.w};
    }
    const u32x4 qwc[2] = {nx.qw[0], nx.qw[1]}, kwc[2] = {nx.kw[0], nx.kw[1]};
    if (HAS_NEXT) g2_load(nx, zq, ag, u_next, tid);
    __syncthreads();
    {
        const int kk = tid & 127, tq = tid >> 7;
        float run = 0.f;
        for (int tt = 0; tt < 16; ++tt) {
            const int t = tq * 16 + tt; float x = bias;
#pragma unroll
            for (int j = 0; j < 16; ++j) x += al[t * 16 + j] * wcol[j];
            run += logsigmoidf_(x) * (1.0f / 16.0f);
            bc[t * 129 + kk] = run;
        }
        qs[tq * 128 + kk] = run;
        __syncthreads();
        float pre = 0.f;
        for (int q = 0; q < tq; ++q) pre += qs[q * 128 + kk];
        for (int tt = 0; tt < 16; ++tt) bc[(tq * 16 + tt) * 129 + kk] += pre;
    }
    __syncthreads();
#pragma unroll
    for (int i = 0; i < 2; ++i) {
        const int c = tid + NTHREADS * i, t = c >> 4, cc = c & 15;
        const size_t qoff = (size_t)(t0 + t) * GLA_Z + h * HK + 8 * cc;
        const u32x4 qw = qwc[i], kw = kwc[i];
        const unsigned qa[4] = {qw.x, qw.y, qw.z, qw.w}, ka[4] = {kw.x, kw.y, kw.z, kw.w};
        unsigned qo[4], ko[4], eo[4];
#pragma unroll
        for (int j = 0; j < 4; ++j) {
            const float b0 = bc[t * 129 + 8 * cc + 2 * j], b1 = bc[t * 129 + 8 * cc + 2 * j + 1];
            const float e0 = bc[63 * 129 + 8 * cc + 2 * j], e1 = bc[63 * 129 + 8 * cc + 2 * j + 1];
            const float q0 = bflo(qa[j]), q1 = bfhi(qa[j]), k0 = bflo(ka[j]), k1 = bfhi(ka[j]);
            qo[j] = cvt_pk_bf16(q0 * 0.08838834764831845f * __expf(b0), q1 * 0.08838834764831845f * __expf(b1));
            ko[j] = cvt_pk_bf16(k0 * __expf(-b0), k1 * __expf(-b1));
            eo[j] = cvt_pk_bf16(k0 * __expf(e0 - b0), k1 * __expf(e1 - b1));
        }
        *(u32x4*)(zq + qoff) = (u32x4){qo[0], qo[1], qo[2], qo[3]};
        *(u32x4*)(zq + qoff + 512) = (u32x4){ko[0], ko[1], ko[2], ko[3]};
        *(LAS u32x2*)(Ke + t * 132 + cc * 8) = (u32x2){eo[0], eo[1]}; *(LAS u32x2*)(Ke + t * 132 + cc * 8 + 4) = (u32x2){eo[2], eo[3]};
    }
    if (tid < 128) bend[u * 128 + tid] = bc[63 * 129 + tid];
    __syncthreads();
    {
        bf16x8 Av[2][2];
#pragma unroll
        for (int vt = 0; vt < 2; ++vt)
#pragma unroll
            for (int ks = 0; ks < 2; ++ks) Av[vt][ks] = lds_col8(V + (32 * ks + 8 * lq) * 260 + 16 * (2 * wave + vt) + l15, 260, l15);
#pragma unroll 2
        for (int kt = 0; kt < 8; ++kt) {
            bf16x8 Bk[2];
#pragma unroll
            for (int ks = 0; ks < 2; ++ks) Bk[ks] = lds_col8(Ke + (32 * ks + 8 * lq) * 132 + 16 * kt + l15, 132, l15);
#pragma unroll
            for (int vt = 0; vt < 2; ++vt) {
                f32x4 acc = (f32x4){0.f, 0.f, 0.f, 0.f};
                acc = mfma16(Bk[0], Av[vt][0], acc); acc = mfma16(Bk[1], Av[vt][1], acc);
                *(unsigned*)(ST + (size_t)u * 32768 + (16 * (2 * wave + vt) + l15) * 128 + 16 * kt + 4 * lq) = pk4_fp8(acc.x, acc.y, acc.z, acc.w);
            }
        }
    }
}
DEVI void phase_g2_fast(const Params& P, int wv, int vc, unsigned char* lds_, int jl) {
    const int tid = opaque_tid(), lane = tid & 63, wave = tid >> 6, l15 = lane & 15, lq = lane >> 4;
    LAS unsigned char* lds = (LAS unsigned char*)lds_;
    bf16_t* zq = (bf16_t*)(P.ws + WS_ZBUF);
    unsigned char* ST = P.ws + WS_BUF2;
    float* bend = (float*)(P.ws + WS_BEND);
    const float* ag = (const float*)(P.ws + WS_AGATE);
    const float* wgu = P.in[I_GLA_WGU] + (size_t)jl * 16 * 512;
    const float* bg = P.in[I_GLA_BG] + jl * 512;
    const int step = (int)(gridDim.x >> 3), ubase = (vc & 7) * 128;
    int ui_ = vc >> 3;
    if (ui_ >= 128) return;
    G2Pre nx;
    g2_load(nx, zq, ag, ubase + ui_, tid);
    for (;;) {
        const int u = ubase + ui_, hk = (u & 3) * HK + (tid & 127);
        float wcol[16];
#pragma unroll
        for (int j = 0; j < 16; ++j) wcol[j] = wgu[j * 512 + hk];
        const float bias = bg[hk];
        if (ui_ + step < 128) { g2_unit<true>(nx, zq, ST, bend, ag, wcol, bias, lds, u, u + step, tid, wave, l15, lq); ui_ += step; }
        else { g2_unit<false>(nx, zq, ST, bend, ag, wcol, bias, lds, u, u, tid, wave, l15, lq); break; }
    }
}

struct G4Pre { u32x2 Bs8[2][4]; u32x2 rr[4][2]; u32x4 qw[2], kw[2], vw[4]; };
DEVI void g4_load(G4Pre& p, const bf16_t* zq, const unsigned char* ST, int u, int tid, int wave, int l15, int lq) {
    const int h = u & 3, n = (u >> 2) & 31, b = u >> 7, t0 = b * SEQ + n * GCH;
#pragma unroll
    for (int nt = 0; nt < 2; ++nt)
#pragma unroll
        for (int ks = 0; ks < 4; ++ks) p.Bs8[nt][ks] = *(const u32x2*)(ST + (size_t)u * 32768 + (16 * (2 * wave + nt) + l15) * 128 + 32 * ks + 8 * lq);
#pragma unroll
    for (int mt = 0; mt < 4; ++mt)
#pragma unroll
        for (int nt = 0; nt < 2; ++nt) p.rr[mt][nt] = *(const u32x2*)(zq + (size_t)(t0 + 16 * mt + l15) * GLA_Z + 2048 + h * HV + 16 * (2 * wave + nt) + 4 * lq);
#pragma unroll
    for (int i = 0; i < 2; ++i) {
        const int c = tid + NTHREADS * i, row = c >> 4, cc = c & 15;
        const size_t qoff = (size_t)(t0 + row) * GLA_Z + h * HK + 8 * cc;
        p.qw[i] = *(const u32x4*)(zq + qoff); p.kw[i] = *(const u32x4*)(zq + qoff + 512);
    }
#pragma unroll
    for (int i = 0; i < 4; ++i) {
        const int c = tid + NTHREADS * i, row = c >> 5, cc = c & 31;
        p.vw[i] = *(const u32x4*)(zq + (size_t)(t0 + row) * GLA_Z + 1024 + h * HV + 8 * cc);
    }
}
template <bool HAS_NEXT>
DEVI void g4_unit(G4Pre& nx, const bf16_t* zq, bf16_t* ob, const unsigned char* ST, const f32x4 (&g4)[2], LAS unsigned char* lds, int u, int u_next, int tid, int wave, int l15, int lq) {
    LAS unsigned char* Q = lds;
    LAS unsigned char* Kd = lds + 17408;
    LAS unsigned short* V = (LAS unsigned short*)(lds + 34816);
    LAS unsigned short* Pm = (LAS unsigned short*)(lds + 68096);
    LAS float* part = (LAS float*)(lds + 77312);
    const int h = u & 3, n = (u >> 2) & 31, b = u >> 7;
    const int t0 = b * SEQ + n * GCH;
    __syncthreads();
    bf16x8 Bs[2][4]; u32x2 rr[4][2];
#pragma unroll
    for (int mt = 0; mt < 4; ++mt)
#pragma unroll
        for (int nt = 0; nt < 2; ++nt) rr[mt][nt] = nx.rr[mt][nt];
#pragma unroll
    for (int i = 0; i < 2; ++i) {
        const int c = tid + NTHREADS * i, row = c >> 4, cc = c & 15;
        *(LAS u32x4*)(Q + row * 272 + cc * 16) = nx.qw[i]; *(LAS u32x4*)(Kd + row * 272 + cc * 16) = nx.kw[i];
    }
#pragma unroll
    for (int i = 0; i < 4; ++i) {
        const int c = tid + NTHREADS * i, row = c >> 5, cc = c & 31;
        const u32x4 w = nx.vw[i];
        *(LAS u32x2*)(V + row * 260 + cc * 8) = (u32x2){w.x, w.y}; *(LAS u32x2*)(V + row * 260 + cc * 8 + 4) = (u32x2){w.z, w.w};
    }
#pragma unroll
    for (int nt = 0; nt < 2; ++nt)
#pragma unroll
        for (int ks = 0; ks < 4; ++ks) {
            const f32x2 s01 = fp8lo2(nx.Bs8[nt][ks].x), s23 = fp8hi2(nx.Bs8[nt][ks].x), s45 = fp8lo2(nx.Bs8[nt][ks].y), s67 = fp8hi2(nx.Bs8[nt][ks].y);
            const u32x4 w = (u32x4){cvt_pk_bf16(s01.x, s01.y), cvt_pk_bf16(s23.x, s23.y), cvt_pk_bf16(s45.x, s45.y), cvt_pk_bf16(s67.x, s67.y)};
            Bs[nt][ks] = __builtin_bit_cast(bf16x8, w);
        }
    if (HAS_NEXT) g4_load(nx, zq, ST, u_next, tid, wave, l15, lq);
    __syncthreads();
    for (int tile = wave; tile < 12; tile += 8) {
        if (tile >= 10) {
            const int ti = tile == 10 ? 0 : 2, tj = ti + 1;
#pragma unroll
            for (int r = 0; r < 4; ++r) Pm[(16 * ti + 4 * lq + r) * 72 + 16 * tj + l15] = 0;
        } else {
            const int ti = tile >= 6 ? 3 : (tile >= 3 ? 2 : (tile >= 1 ? 1 : 0)), tj = tile - (ti * (ti + 1)) / 2;
            f32x4 acc = (f32x4){0.f, 0.f, 0.f, 0.f};
#pragma unroll
            for (int ks = 0; ks < 4; ++ks) {
                const bf16x8 a = *(const LAS bf16x8*)(Q + (16 * ti + l15) * 272 + (32 * ks + 8 * lq) * 2);
                const bf16x8 bb = *(const LAS bf16x8*)(Kd + (16 * tj + l15) * 272 + (32 * ks + 8 * lq) * 2);
                acc = mfma16(a, bb, acc);
            }
#pragma unroll
            for (int r = 0; r < 4; ++r) {
                const int i = 16 * ti + 4 * lq + r, j = 16 * tj + l15;
                Pm[i * 72 + j] = (unsigned short)f2bf(j <= i ? acc[r] : 0.f);
            }
        }
    }
    __syncthreads();
    f32x4 acc[4][2];
    {
        bf16x8 Bv[2][2];
#pragma unroll
        for (int nt = 0; nt < 2; ++nt)
#pragma unroll
            for (int ks = 0; ks < 2; ++ks) Bv[nt][ks] = lds_col8(V + (32 * ks + 8 * lq) * 260 + 16 * (2 * wave + nt) + l15, 260, l15);
#pragma unroll
        for (int mt = 0; mt < 4; ++mt) {
            acc[mt][0] = (f32x4){0.f, 0.f, 0.f, 0.f}; acc[mt][1] = (f32x4){0.f, 0.f, 0.f, 0.f};
#pragma unroll
            for (int ks = 0; ks < 2; ++ks) if (ks <= ((16 * mt + 15) >> 5)) {
                const bf16x8 ap = *(const LAS bf16x8*)((const LAS unsigned char*)Pm + (16 * mt + l15) * 144 + (32 * ks + 8 * lq) * 2);
                acc[mt][0] = mfma16(Bv[0][ks], ap, acc[mt][0]); acc[mt][1] = mfma16(Bv[1][ks], ap, acc[mt][1]);
            }
#pragma unroll
            for (int ks = 0; ks < 4; ++ks) {
                const bf16x8 aq = *(const LAS bf16x8*)(Q + (16 * mt + l15) * 272 + (32 * ks + 8 * lq) * 2);
                acc[mt][0] = mfma16(Bs[0][ks], aq, acc[mt][0]); acc[mt][1] = mfma16(Bs[1][ks], aq, acc[mt][1]);
            }
        }
    }
#pragma unroll
    for (int mt = 0; mt < 4; ++mt) {
        float s2 = 0.f;
#pragma unroll
        for (int nt = 0; nt < 2; ++nt) s2 += acc[mt][nt].x * acc[mt][nt].x + acc[mt][nt].y * acc[mt][nt].y + acc[mt][nt].z * acc[mt][nt].z + acc[mt][nt].w * acc[mt][nt].w;
        s2 += __shfl_xor(s2, 16); s2 += __shfl_xor(s2, 32);
        if (lq == 0) part[wave * 64 + 16 * mt + l15] = s2;
    }
    __syncthreads();
#pragma unroll
    for (int mt = 0; mt < 4; ++mt) {
        const int i = 16 * mt + l15; float tot = 0.f;
#pragma unroll
        for (int w8 = 0; w8 < 8; ++w8) tot += part[w8 * 64 + i];
        const float rs = rsqrtf(tot * (1.0f / HV) + EPS);
#pragma unroll
        for (int nt = 0; nt < 2; ++nt) {
            const int vv = 16 * (2 * wave + nt) + 4 * lq;
            const float r0 = bflo(rr[mt][nt].x), r1 = bfhi(rr[mt][nt].x), r2 = bflo(rr[mt][nt].y), r3 = bfhi(rr[mt][nt].y);
            const f32x4 a = acc[mt][nt];
            u32x2 o; o.x = cvt_pk_bf16(a.x * rs * g4[nt].x * siluf_(r0), a.y * rs * g4[nt].y * siluf_(r1)); o.y = cvt_pk_bf16(a.z * rs * g4[nt].z * siluf_(r2), a.w * rs * g4[nt].w * siluf_(r3));
            *(u32x2*)(ob + (size_t)(t0 + i) * 1024 + h * HV + vv) = o;
        }
    }
}
DEVI void phase_g4_fast(const Params& P, int wv, int vc, unsigned char* lds_, int jl) {
    const int tid = opaque_tid(), lane = tid & 63, wave = tid >> 6, l15 = lane & 15, lq = lane >> 4;
    LAS unsigned char* lds = (LAS unsigned char*)lds_;
    const bf16_t* zq = (const bf16_t*)(P.ws + WS_ZBUF);
    bf16_t* ob = (bf16_t*)(P.ws + WS_ZBUF + ZB_OB);
    const unsigned char* ST = P.ws + WS_BUF2;
    const float* gh = P.in[I_GLA_GH] + jl * 1024;
    const int step = (int)(gridDim.x >> 3), ubase = (vc & 7) * 128;
    int ui_ = vc >> 3;
    if (ui_ >= 128) return;
    f32x4 g4[2];
    G4Pre nx;
    g4_load(nx, zq, ST, ubase + ui_, tid, wave, l15, lq);
    for (;;) {
        const int u = ubase + ui_, h = u & 3;
#pragma unroll
        for (int nt = 0; nt < 2; ++nt) g4[nt] = *(const f32x4*)(gh + h * HV + 16 * (2 * wave + nt) + 4 * lq);
        if (ui_ + step < 128) { g4_unit<true>(nx, zq, ob, ST, g4, lds, u, u + step, tid, wave, l15, lq); ui_ += step; }
        else { g4_unit<false>(nx, zq, ob, ST, g4, lds, u, u, tid, wave, l15, lq); break; }
    }
}

struct S2Pre { f32x4 sv[4]; u32x4 vw[4]; unsigned uu[8][2]; };
DEVI void s2_load(S2Pre& p, const unsigned char* z, const float* lnstat, int u, int tid, int wave, int l15, int lq) {
    const int g = u & 7, n = (u >> 3) & 15, b = u >> 7, t0 = b * SEQ + n * SCH;
#pragma unroll
    for (int q = 0; q < 4; ++q) p.sv[q] = *(const f32x4*)(lnstat + (size_t)(t0 + (tid >> 2)) * 64 + 16 * (tid & 3) + 4 * q);
    const int col = g * SGC + (tid & 15) * 16;
#pragma unroll
    for (int i = 0; i < 4; ++i) p.vw[i] = *(const u32x4*)(z + (size_t)(t0 + (tid >> 4) + 32 * i) * SGU_Z + SGU_W + col);
#pragma unroll
    for (int tt = 0; tt < 8; ++tt)
#pragma unroll
        for (int ct = 0; ct < 2; ++ct) p.uu[tt][ct] = *(const unsigned*)(z + (size_t)(t0 + 16 * tt + l15) * SGU_Z + g * SGC + 16 * (2 * wave + ct) + 4 * lq);
}
template <bool HAS_NEXT>
DEVI void s2_unit(S2Pre& nx, const unsigned char* z, bf16_t* ug, const float* lnstat, const float (&gg)[16], const float (&bb)[16], const float (&bias8)[8], LAS unsigned char* lds, int u, int u_next,
                  int tid, int wave, int l15, int lq) {
    LAS unsigned short* X = (LAS unsigned short*)lds;
    LAS unsigned char* Wl = lds + 66560;
    LAS float* mu = (LAS float*)(lds + 101376); LAS float* rsd = mu + 128;
    const int g = u & 7, n = (u >> 3) & 15, b = u >> 7;
    const int t0 = b * SEQ + n * SCH;
    {
        float s1 = 0.f, s2 = 0.f;
#pragma unroll
        for (int q = 0; q < 4; ++q) { s1 += nx.sv[q].x; s2 += nx.sv[q].y; s1 += nx.sv[q].z; s2 += nx.sv[q].w; }
        s1 += __shfl_xor(s1, 1); s2 += __shfl_xor(s2, 1); s1 += __shfl_xor(s1, 2); s2 += __shfl_xor(s2, 2);
        const float mean = s1 * (1.0f / SGU_W); const float var = fmaxf(s2 * (1.0f / SGU_W) - mean * mean, 0.f);
        if ((tid & 3) == 0) { mu[tid >> 2] = mean; rsd[tid >> 2] = rsqrtf(var + EPS); }
    }
    u32x4 vw[4]; unsigned uu[8][2];
#pragma unroll
    for (int i = 0; i < 4; ++i) vw[i] = nx.vw[i];
#pragma unroll
    for (int tt = 0; tt < 8; ++tt) { uu[tt][0] = nx.uu[tt][0]; uu[tt][1] = nx.uu[tt][1]; }
    if (HAS_NEXT) s2_load(nx, z, lnstat, u_next, tid, wave, l15, lq);
    __syncthreads();
    {
        const int cc = tid & 15;
#pragma unroll
        for (int i = 0; i < 4; ++i) {
            const int s = (tid >> 4) + 32 * i;
            const u32x4 w = vw[i];
            const float m = mu[s], r = rsd[s];
            const unsigned wa[4] = {w.x, w.y, w.z, w.w}; unsigned o[8];
#pragma unroll
            for (int j = 0; j < 4; ++j) {
                const f32x2 a = fp8lo2(wa[j]), c = fp8hi2(wa[j]);
                o[2 * j] = cvt_pk_bf16((a.x - m) * r * gg[4 * j] + bb[4 * j], (a.y - m) * r * gg[4 * j + 1] + bb[4 * j + 1]);
                o[2 * j + 1] = cvt_pk_bf16((c.x - m) * r * gg[4 * j + 2] + bb[4 * j + 2], (c.y - m) * r * gg[4 * j + 3] + bb[4 * j + 3]);
            }
#pragma unroll
            for (int j = 0; j < 4; ++j) *(LAS u32x2*)(X + s * 260 + cc * 16 + 4 * j) = (u32x2){o[2 * j], o[2 * j + 1]};
        }
    }
    __syncthreads();
    {
        bf16x8 Bf[2][4];
#pragma unroll
        for (int ct = 0; ct < 2; ++ct)
#pragma unroll
            for (int ks = 0; ks < 4; ++ks) Bf[ct][ks] = lds_col8(X + (32 * ks + 8 * lq) * 260 + 16 * (2 * wave + ct) + l15, 260, l15);
#pragma unroll
        for (int tt = 0; tt < 8; ++tt) {
            f32x4 acc0 = (f32x4){0.f, 0.f, 0.f, 0.f}, acc1 = (f32x4){0.f, 0.f, 0.f, 0.f};
#pragma unroll
            for (int ks = 0; ks < 4; ++ks) if (ks <= ((16 * tt + 15) >> 5)) {
                const bf16x8 af = *(const LAS bf16x8*)(Wl + (16 * tt + l15) * 272 + (32 * ks + 8 * lq) * 2);
                acc0 = mfma16(Bf[0][ks], af, acc0); acc1 = mfma16(Bf[1][ks], af, acc1);
            }
            const int t = 16 * tt + l15; const float bias = bias8[tt];
#pragma unroll
            for (int ct = 0; ct < 2; ++ct) {
                const f32x4 a = ct ? acc1 : acc0; const unsigned uw = uu[tt][ct];
                const f32x2 u01 = gelu_tanh2(fp8lo2(uw)), u23 = gelu_tanh2(fp8hi2(uw));
                u32x2 o; o.x = cvt_pk_bf16(u01.x * (a.x + bias), u01.y * (a.y + bias)); o.y = cvt_pk_bf16(u23.x * (a.z + bias), u23.y * (a.w + bias));
                *(u32x2*)(ug + (size_t)(t0 + t) * SGU_W + g * SGC + 16 * (2 * wave + ct) + 4 * lq) = o;
            }
        }
    }
}
DEVI void phase_s2_fast(const Params& P, int wv, int vc, unsigned char* lds_, int jl) {
    const int tid = opaque_tid(), lane = tid & 63, wave = tid >> 6, l15 = lane & 15, lq = lane >> 4;
    LAS unsigned char* lds = (LAS unsigned char*)lds_;
    LAS unsigned char* Wl = lds + 66560;
    const unsigned char* z = P.ws + WS_ZBUF;
    bf16_t* ug = (bf16_t*)(P.ws + WS_BUF2);
    const float* lnstat = (const float*)(P.ws + WS_LNP) + (size_t)jl * T * 64;
    const bf16_t* wsb = (const bf16_t*)(P.ws + WS_SGUWS) + (size_t)jl * 8 * 128 * 128;
    const float* lng = P.in[I_SGU_LNG] + jl * SGU_W; const float* lnb = P.in[I_SGU_LNB] + jl * SGU_W;
    const float* bs = P.in[I_SGU_BS] + jl * 8 * 128;
    const int step = (int)(gridDim.x >> 3), ubase = (vc & 7) * 128;
    int ui_ = vc >> 3, gcur = -1;
    if (ui_ >= 128) return;
    S2Pre nx;
    s2_load(nx, z, lnstat, ubase + ui_, tid, wave, l15, lq);
    for (;;) {
        const int u = ubase + ui_, g = u & 7;
        __syncthreads();
        if (g != gcur) {
#pragma unroll
            for (int i = 0; i < 4; ++i) { const int q = tid + NTHREADS * i, t = q >> 4, cc = q & 15; *(LAS u32x4*)(Wl + t * 272 + cc * 16) = *(const u32x4*)(wsb + (size_t)g * 16384 + t * 128 + cc * 8); }
            gcur = g;
        }
        float gg[16], bb[16], bias8[8];
        { const int col = g * SGC + (tid & 15) * 16;
#pragma unroll
          for (int e = 0; e < 16; ++e) { gg[e] = lng[col + e]; bb[e] = lnb[col + e]; }
#pragma unroll
          for (int tt = 0; tt < 8; ++tt) bias8[tt] = bs[g * 128 + 16 * tt + l15]; }
        if (ui_ + step < 128) { s2_unit<true>(nx, z, ug, lnstat, gg, bb, bias8, lds, u, u + step, tid, wave, l15, lq); ui_ += step; }
        else { s2_unit<false>(nx, z, ug, lnstat, gg, bb, bias8, lds, u, u, tid, wave, l15, lq); break; }
    }
}

DEVI void phase_router(const Params& P, int wv, int vc, unsigned char* lds, int layer) {
    const int tid = opaque_tid(), lane = tid & 63, wave = tid >> 6, l15 = lane & 15, lq = lane >> 4;
    LAS unsigned char* Bw = (LAS unsigned char*)lds;
    float* red = (float*)(lds + 132096);
    float* lgt = (float*)(lds + 144384);
    float* ssqt = (float*)(lds + 152576);
    int* r_cls = (int*)(lds + 152832);
    float* r_wlo = (float*)(lds + 152832 + 256);
    float* r_whi = (float*)(lds + 152832 + 512);
    float* r_rs = (float*)(lds + 152832 + 768);
    int* c_base = (int*)(lds + 152832 + 1024);
    const bf16_t* wr = (const bf16_t*)(P.ws + WS_WR) + (size_t)layer * 2 * 32 * D;
    const bf16_t* h = (const bf16_t*)(P.ws + WS_HB1);
    int* cnt = (int*)(P.ws + CTL_CNT) + layer * 32 * CNT_STRIDE;
    int* list = (int*)(P.ws + WS_LIST);
    f32x4* tokinfo = (f32x4*)(P.ws + WS_TOKINFO);
    float brg[4], bre[16];
#pragma unroll
    for (int g = 0; g < 4; ++g) brg[g] = P.in[I_BRG][layer * 4 + g];
#pragma unroll
    for (int e = 0; e < 16; ++e) bre[e] = P.in[I_BRE][layer * 16 + e];
    const int rstep = (int)(gridDim.x >> 3);
    bf16x8 av[16];
    {
        const int bi0 = vc >> 3;
        if (bi0 < 32) {
            const bf16_t* ap = h + (size_t)(((vc & 7) * 32 + bi0) * 64 + 16 * (wave & 3) + l15) * D + (wave >> 2) * 512 + 8 * lq;
#pragma unroll
            for (int ks = 0; ks < 16; ++ks) av[ks] = *(const bf16x8*)(ap + 32 * ks);
        }
    }
    {
        u32x4 wv4[16];
#pragma unroll
        for (int i = 0; i < 16; ++i) wv4[i] = ((const u32x4*)wr)[tid + NTHREADS * i];
#pragma unroll
        for (int i = 0; i < 16; ++i) { const int q = tid + NTHREADS * i; *(LAS u32x4*)(Bw + (q >> 7) * 2064 + (q & 127) * 16) = wv4[i]; }
    }
    __syncthreads();
    for (int bi_ = vc >> 3; bi_ < 32; bi_ += rstep) {
        const int blk = (vc & 7) * 32 + bi_;
        {
            const int mt = wave & 3, kh = wave >> 2;
            const LAS unsigned char* bp = Bw + l15 * 2064 + (kh * 512 + 8 * lq) * 2;
            f32x4 acc0 = (f32x4){0.f, 0.f, 0.f, 0.f}, acc1 = (f32x4){0.f, 0.f, 0.f, 0.f}; float ss = 0.f;
            bf16x8 ac[16];
#pragma unroll
            for (int ks = 0; ks < 16; ++ks) ac[ks] = av[ks];
            if (bi_ + rstep < 32) {
                const bf16_t* ap = h + (size_t)(((vc & 7) * 32 + bi_ + rstep) * 64 + 16 * mt + l15) * D + kh * 512 + 8 * lq;
#pragma unroll
                for (int ks = 0; ks < 16; ++ks) av[ks] = *(const bf16x8*)(ap + 32 * ks);
            }
#pragma unroll
            for (int ks = 0; ks < 16; ++ks) {
                const bf16x8 a = ac[ks];
                const u32x4 aw = __builtin_bit_cast(u32x4, a);
                ss += bflo(aw.x) * bflo(aw.x) + bfhi(aw.x) * bfhi(aw.x) + bflo(aw.y) * bflo(aw.y) + bfhi(aw.y) * bfhi(aw.y) + bflo(aw.z) * bflo(aw.z) + bfhi(aw.z) * bfhi(aw.z) + bflo(aw.w) * bflo(aw.w) + bfhi(aw.w) * bfhi(aw.w);
                acc0 = mfma16(*(const LAS bf16x8*)(bp + 64 * ks), a, acc0);
                acc0 = mfma16(*(const LAS bf16x8*)(bp + 32 * 2064 + 64 * ks), a, acc0);
                acc1 = mfma16(*(const LAS bf16x8*)(bp + 16 * 2064 + 64 * ks), a, acc1);
                acc1 = mfma16(*(const LAS bf16x8*)(bp + 48 * 2064 + 64 * ks), a, acc1);
            }
            ss += __shfl_xor(ss, 16); ss += __shfl_xor(ss, 32);
            __syncthreads();
            if (kh == 1) { float* rp = red + (mt * 64 + lane) * 12; *(f32x4*)rp = acc0; *(f32x4*)(rp + 4) = acc1; rp[8] = ss; }
            __syncthreads();
            if (kh == 0) {
                const float* rp = red + (mt * 64 + lane) * 12;
                acc0 += *(const f32x4*)rp; acc1 += *(const f32x4*)(rp + 4); ss += rp[8];
                float* lp = lgt + (16 * mt + l15) * 32 + 4 * lq;
                *(f32x4*)lp = acc0; *(f32x4*)(lp + 16) = acc1;
                if (lq == 0) ssqt[16 * mt + l15] = ss;
            }
            __syncthreads();
        }
        if (tid < 64) {
            const int rl = tid;
            const float rs = rstd_from_ssq(ssqt[rl]);
            float lg[20];
#pragma unroll
            for (int o = 0; o < 20; ++o) lg[o] = lgt[rl * 32 + o] * rs;
            float gl[4]; int gi = 0;
#pragma unroll
            for (int g = 0; g < 4; ++g) gl[g] = lg[g] + brg[g];
            float gm = gl[0];
#pragma unroll
            for (int g = 1; g < 4; ++g) if (gl[g] > gm) { gm = gl[g]; gi = g; }
            float den = 0.f;
#pragma unroll
            for (int g = 0; g < 4; ++g) den += __expf(gl[g] - gm);
            const float gw = 1.0f / den;
            float el[4];
#pragma unroll
            for (int e = 0; e < 4; ++e) {
                float v = lg[4 + e] + bre[e];
                v = gi == 1 ? lg[8 + e] + bre[4 + e] : v; v = gi == 2 ? lg[12 + e] + bre[8 + e] : v; v = gi == 3 ? lg[16 + e] + bre[12 + e] : v;
                el[e] = v;
            }
            int i1 = 0; float v1 = el[0];
#pragma unroll
            for (int e = 1; e < 4; ++e) if (el[e] > v1) { v1 = el[e]; i1 = e; }
            int i2 = -1; float v2 = -3.0e38f;
#pragma unroll
            for (int e = 0; e < 4; ++e) if (e != i1 && el[e] > v2) { v2 = el[e]; i2 = e; }
            const float ex = __expf(v2 - v1); const float w1 = gw / (1.0f + ex), w2 = gw * ex / (1.0f + ex);
            const int lo = i1 < i2 ? i1 : i2, hi = i1 < i2 ? i2 : i1;
            const float wlo = i1 < i2 ? w1 : w2, whi = i1 < i2 ? w2 : w1;
            const int pair = lo == 0 ? hi - 1 : (lo == 1 ? hi + 1 : 5);
            r_cls[rl] = gi * 6 + pair; r_wlo[rl] = wlo; r_whi[rl] = whi; r_rs[rl] = rs;
        }
        __syncthreads();
        int cb = 0, myc = 0, rank = 0;
        if (tid < NCLS) { int c = 0; for (int r = 0; r < 64; ++r) c += (r_cls[r] == tid) ? 1 : 0; if (c) cb = atomicAdd(cnt + tid * CNT_STRIDE, c); }
        if (tid < 64) { myc = r_cls[tid]; for (int r = 0; r < tid; ++r) rank += (r_cls[r] == myc) ? 1 : 0; }
        if (tid < NCLS) c_base[tid] = cb;
        __syncthreads();
        if (tid < 64) {
            const int row = blk * 64 + tid;
            list[(size_t)myc * T + c_base[myc] + rank] = row;
            tokinfo[row] = (f32x4){r_rs[tid], r_wlo[tid], r_whi[tid], 0.f};
        }
        __syncthreads();
    }
}

DEVI void phase_final(const Params& P, int wv, int vc) {
    const int tid = opaque_tid(), lane = tid & 63, wave = tid >> 6;
    const int lw = (vc >> 3) * NWAVES + wave, nlw = (int)(gridDim.x >> 3) * NWAVES, rbase = (vc & 7) * SEQ;
    const bf16_t* h = (const bf16_t*)(P.ws + WS_HB0); const float* g = P.in[I_FINAL];
    f32x4 gg[4];
#pragma unroll
    for (int q = 0; q < 4; ++q) gg[q] = *(const f32x4*)(g + (q >> 1) * 512 + 8 * lane + 4 * (q & 1));
    for (int r0 = lw; r0 < SEQ; r0 += 8 * nlw) {
        u32x4 w[8][2];
#pragma unroll
        for (int r = 0; r < 8; ++r) { const int rr = r0 + r * nlw; const u32x4* hr = (const u32x4*)(h + (size_t)(rbase + (rr < SEQ ? rr : 0)) * D) + lane; w[r][0] = hr[0]; w[r][1] = hr[64]; }
#pragma unroll
        for (int r = 0; r < 8; ++r) {
            const int rr = r0 + r * nlw; if (rr < SEQ) {
            const int row = rbase + rr;
            const u32x4 w0 = w[r][0], w1 = w[r][1];
            float v[16] = {bflo(w0.x), bfhi(w0.x), bflo(w0.y), bfhi(w0.y), bflo(w0.z), bfhi(w0.z), bflo(w0.w), bfhi(w0.w), bflo(w1.x), bfhi(w1.x), bflo(w1.y), bfhi(w1.y), bflo(w1.z), bfhi(w1.z), bflo(w1.w), bfhi(w1.w)};
            float ss = 0.f;
#pragma unroll
            for (int j = 0; j < 16; ++j) ss += v[j] * v[j];
            ss = wave_sum(ss);
            const float rs = rstd_from_ssq(ss);
#pragma unroll
            for (int q = 0; q < 4; ++q) {
                const int col = (q >> 1) * 512 + 8 * lane + 4 * (q & 1);
                *(f32x4*)(P.out + (size_t)row * D + col) = (f32x4){v[4 * q] * rs * gg[q].x, v[4 * q + 1] * rs * gg[q].y, v[4 * q + 2] * rs * gg[q].z, v[4 * q + 3] * rs * gg[q].w};
            }
            }
        }
    }
}

DEVI float* ssq_ptr(const Params& P, int wv, int vc, int layer, int which) { return (float*)(P.ws + WS_SSQP) + (size_t)(layer * 2 + which) * T * 16; }

DEVI void phase_g1_gemm(const Params& P, int wv, int vc, unsigned char* lds, int jl, int layer) {
    PlainSched S; S.init((const bf16_t*)(P.ws + WS_HB0), D, (const bf16_t*)(P.ws + WS_GLA_IN) + (size_t)jl * GLA_IN * D, D, T, GLA_Z, gridDim.x, vc);
    const RstdHook<PlainSched> hook{wv, lds, &S, ssq_ptr(P, wv, vc, layer, 0)};
    EpiZ E{(bf16_t*)(P.ws + WS_ZBUF), GLA_Z, (const LAS float*)((LAS unsigned char*)lds + LDS_RTAB), 0, nullptr, 0};
    gemm_run<false>(wv, lds, GemmShape{D, D, D, D, false}, S, E, hook);
}
DEVI void phase_s1_gemm(const Params& P, int wv, int vc, unsigned char* lds, int jl, int layer) {
    PlainSched S; S.init((const bf16_t*)(P.ws + WS_HB0), D, (const bf16_t*)(P.ws + WS_SGU_IN) + (size_t)jl * SGU_Z * D, D, T, SGU_Z, gridDim.x, vc);
    const RstdHook<PlainSched> hook{wv, lds, &S, ssq_ptr(P, wv, vc, layer, 0)};
    EpiZT<true> E{(bf16_t*)(P.ws + WS_ZBUF), SGU_Z, (const LAS float*)((LAS unsigned char*)lds + LDS_RTAB), 1, (float*)(P.ws + WS_LNP) + (size_t)jl * T * 64, 8};
    gemm_run<false>(wv, lds, GemmShape{D, D, D, D, false}, S, E, hook);
}
DEVI void phase_mixout_gemm(const Params& P, int wv, int vc, unsigned char* lds, int jl, int layer, bool gla) {
    EpiRes<false> E{(const bf16_t*)(P.ws + WS_HB0), (bf16_t*)(P.ws + WS_HB1), nullptr, nullptr, nullptr};
    PlainSched S;
    if (gla) { S.init((const bf16_t*)(P.ws + WS_ZBUF + ZB_OB), D, (const bf16_t*)(P.ws + WS_GLA_OUT) + (size_t)jl * D * D, D, T, D, gridDim.x, vc); gemm_run<false>(wv, lds, GemmShape{D, D, D, D, false}, S, E); }
    else { S.init((const bf16_t*)(P.ws + WS_BUF2), SGU_W, (const bf16_t*)(P.ws + WS_SGU_OUT) + (size_t)jl * D * SGU_W, SGU_W, T, D, gridDim.x, vc); gemm_run<false>(wv, lds, GemmShape{SGU_W, SGU_W, SGU_W, SGU_W, false}, S, E); }
}
struct FillSched {
    const bf16_t* A; const bf16_t* Bt; int lda, ldb, j, stride, ntot;
    DEVI bool next(int i, Unit& u) const {
        if (j < 0) return false;
        const int un = j + i * stride; if (un >= ntot) return false;
        u.pm = un >> 2; u.pn = un & 3; u.A = A + (size_t)u.pm * 256 * lda; u.rows = nullptr; u.nvalid = 256; u.B0 = Bt + (size_t)u.pn * 256 * ldb; u.B1 = u.B0; u.aux0 = 0; u.aux1 = 0; u.idx = i;
        return true;
    }
};
DEVI void phase_pleup_gemm(const Params& P, int wv, int vc, unsigned char* lds, int layer, int n_gemm_units, bool grp) {
    int G = gridDim.x, c = vc;
    int j, stride;
    if (grp) {
        const int ntile_all = __builtin_amdgcn_readfirstlane(((const LAS int*)((LAS unsigned char*)lds + LDS_SCHED))[NCLS]);
        const int G32 = G >> 3, x = vc & 7, rank = vc >> 3, q = ntile_all >> 3, rem = ntile_all & 7;
        int idle_before = 0, idle_total = 0, my_c0 = G32;
#pragma unroll 1
        for (int xx = 0; xx < 8; ++xx) {
            const int nt = q + (xx < rem ? 1 : 0), n2 = 8 * nt, n3 = 4 * nt;
            const int nA = n2 < 2 * G32 ? n2 : 2 * G32, nB = n2 - nA, wB = nB < G32 ? nB : G32, dB = (G32 - wB) < n3 ? (G32 - wB) : n3, nC = n3 - dB;
            const int idle = nC < G32 ? G32 - nC : 0;
            if (xx < x) idle_before += idle;
            if (xx == x) my_c0 = nC < G32 ? nC : G32;
            idle_total += idle;
        }
        if (3 * idle_total >= 256) { j = rank >= my_c0 ? idle_before + rank - my_c0 : -1; stride = idle_total; }
        else { j = vc; stride = G; }
        (void)n_gemm_units; (void)c;
    } else {
        int c0 = __builtin_amdgcn_readfirstlane(n_gemm_units); while (c0 > G) c0 -= G;
        if (3 * (G - c0) >= G) { j = c >= c0 ? c - c0 : -1; stride = G - c0; }
        else { j = c; stride = G; }
    }
    FillSched S{(const bf16_t*)(P.ws + WS_PB), (const bf16_t*)(P.ws + WS_PLE_UP) + (size_t)layer * D * PLE, PLE, PLE, j, stride, 256};
    EpiZ E{(bf16_t*)(P.ws + WS_UPLE), D, nullptr, 0, nullptr, 0};
    gemm_run<false>(wv, lds, GemmShape{PLE, PLE, PLE, PLE, false}, S, E);
}
DEVI void phase_moe_up(const Params& P, int wv, int vc, unsigned char* lds, int layer, int mode, bool grp) {
    LAS int* pre = (LAS int*)((LAS unsigned char*)lds + LDS_SCHED); LAS int* cn = pre + 32; LAS int* rl = pre + 64;
    (void)moe_sched_setup(P, wv, vc, layer, pre, cn, rl, 8, mode, grp);
    MoeSched S{pre, cn, rl, 8, (int)gridDim.x, vc, true, (const bf16_t*)(P.ws + WS_HB1), (const bf16_t*)(P.ws + WS_MOE_UP)};
    EpiAct E{(bf16_t*)(P.ws + WS_ZBUF), (const f32x4*)(P.ws + WS_TOKINFO)};
    gemm_run<true>(wv, lds, GemmShape{D, D, D, D, true}, S, E, NoHook{}, MoeListHook{wv, pre, cn, rl, (const int*)(P.ws + WS_LIST), true});
}
DEVI int phase_moe_down(const Params& P, int wv, int vc, unsigned char* lds, int layer, int mode, bool grp) {
    LAS int* pre = (LAS int*)((LAS unsigned char*)lds + LDS_SCHED); LAS int* cn = pre + 32; LAS int* rl = pre + 64;
    const int N = moe_sched_setup(P, wv, vc, layer, pre, cn, rl, 4, mode, grp);
    MoeSched S{pre, cn, rl, 4, (int)gridDim.x, vc, false, (const bf16_t*)(P.ws + WS_ZBUF), (const bf16_t*)(P.ws + WS_MOE_DN)};
    EpiRes<false> E{(const bf16_t*)(P.ws + WS_HB1), (bf16_t*)(P.ws + WS_HB1), ssq_ptr(P, wv, vc, layer, 1), nullptr, nullptr};
    gemm_run<false>(wv, lds, GemmShape{1024, 512, 1024, 512, false}, S, E, MoeListHook{wv, pre, cn, rl, (const int*)(P.ws + WS_LIST), false});
    return N;
}
DEVI void phase_ple_gemm(const Params& P, int wv, int vc, unsigned char* lds, int layer) {
    PlainSched S; S.init((const bf16_t*)(P.ws + WS_HB1), D, (const bf16_t*)(P.ws + WS_PLE_GATE) + (size_t)layer * D * D, D, T, D, gridDim.x, vc);
    const RstdHook<PlainSched> hook{wv, lds, &S, ssq_ptr(P, wv, vc, layer, 1)};
    EpiRes<true> E{(const bf16_t*)(P.ws + WS_HB1), (bf16_t*)(P.ws + WS_HB0), layer < NLAYER - 1 ? ssq_ptr(P, wv, vc, layer + 1, 0) : nullptr, (const bf16_t*)(P.ws + WS_UPLE), (const LAS float*)((LAS unsigned char*)lds + LDS_RTAB)};
    gemm_run<false>(wv, lds, GemmShape{D, D, D, D, false}, S, E, hook);
}

#define XB_TMO      128
#define XB_XCNT(j)  (256  + 64 * (j))
#define XB_XSUB(j)  (1280 + 64 * (j))
#define XB_XGEN(j)  (2304 + 64 * (j))
#define XB_TOP      3328
#define XB_TOPGEN   3392
#define XCD_BAR_WORDS 3456
#define XB_SPIN_CAP (1u << 18)
__device__ __forceinline__ unsigned xb_ld(unsigned* p)              { return __hip_atomic_load(p, __ATOMIC_RELAXED, __HIP_MEMORY_SCOPE_AGENT); }
__device__ __forceinline__ unsigned xb_add(unsigned* p, unsigned v) { return __hip_atomic_fetch_add(p, v, __ATOMIC_RELAXED, __HIP_MEMORY_SCOPE_AGENT); }
__device__ __forceinline__ unsigned xb_xcc_id() { return (unsigned)__builtin_amdgcn_s_getreg((3 << 11) | 20) & 0xFu; }
#define XB_SPIN(cond, bar) do { unsigned _sp = 0; while (cond) { __builtin_amdgcn_s_sleep(1); \
    if ((++_sp & 255u) == 0u) { if (xb_ld(&(bar)[XB_TMO])) break; if (_sp > XB_SPIN_CAP) { atomicAdd(&(bar)[XB_TMO], 1u); break; } } } } while (0)
struct XcdBarrier {
    unsigned* bar; unsigned x;
    volatile LAS unsigned* st;
};
__device__ __forceinline__ XcdBarrier xcd_barrier_post(unsigned* bar, volatile LAS unsigned* st) {
    XcdBarrier b; b.bar = bar; b.x = (unsigned)__builtin_amdgcn_readfirstlane((int)xb_xcc_id()); b.st = st;
    if (threadIdx.x == 0) (void)xb_add(&bar[XB_XCNT(b.x)], 1u);
    return b;
}
__device__ __forceinline__ void xcd_barrier_complete(unsigned* bar, unsigned x, unsigned& nloc, unsigned& nx) {
    const unsigned G = gridDim.x * gridDim.y * gridDim.z;
    unsigned sum, cnt, mine, sp = 0u;
    for (;;) {
        sum = 0u; cnt = 0u; mine = 0u;
#pragma unroll
        for (unsigned j = 0; j < 16; ++j) { const unsigned c = xb_ld(&bar[XB_XCNT(j)]); sum += c; cnt += (c > 0u) ? 1u : 0u; mine = (j == x) ? c : mine; }
        if (sum == G) break;
        __builtin_amdgcn_s_sleep(1);
        if ((++sp & 255u) == 0u) { if (xb_ld(&bar[XB_TMO])) break; if (sp > XB_SPIN_CAP) { atomicAdd(&bar[XB_TMO], 1u); break; } }
    }
    nloc = mine > 0u ? mine : 1u; nx = cnt > 0u ? cnt : 1u;
}
__device__ __forceinline__ void xcd_barrier(const XcdBarrier& b) {
    asm volatile("s_waitcnt vmcnt(0)" ::: "memory");
    __syncthreads();
    if (threadIdx.x == 0) {
        unsigned* bar = b.bar; unsigned bx = b.x;
        asm volatile("" : "+s"(bar), "+s"(bx));
        __builtin_amdgcn_s_waitcnt(0);
        unsigned nloc = b.st[0], nx = b.st[1];
        if (nloc == 0u) { xcd_barrier_complete(bar, bx, nloc, nx); b.st[0] = nloc; b.st[1] = nx; }
        const unsigned old = xb_add(&bar[XB_XSUB(bx)], 1u);
        const unsigned gen = old / nloc;
        if (old + 1u == (gen + 1u) * nloc) {
            __builtin_amdgcn_fence(__ATOMIC_RELEASE, "agent");
            asm volatile("s_waitcnt vmcnt(0)" ::: "memory");
            const unsigned og = xb_add(&bar[XB_TOP], 1u);
            const unsigned tg = og / nx;
            if (og + 1u == (tg + 1u) * nx) xb_add(&bar[XB_TOPGEN], 1u);
            else XB_SPIN(xb_ld(&bar[XB_TOPGEN]) == tg, bar);
            __builtin_amdgcn_fence(__ATOMIC_ACQUIRE, "agent");
            xb_add(&bar[XB_XGEN(bx)], 1u);
            asm volatile("s_waitcnt vmcnt(0)" ::: "memory");
        } else {
            XB_SPIN(xb_ld(&bar[XB_XGEN(bx)]) == gen, bar);
            __builtin_amdgcn_fence(__ATOMIC_ACQUIRE, "agent");
            asm volatile("s_waitcnt vmcnt(0)" ::: "memory");
        }
    }
    __syncthreads();
}

constexpr size_t CTL_ROLE = 98304;
constexpr size_t CTL_LB = 106496;
__device__ __forceinline__ void xcd_local_barrier(unsigned* cw, unsigned target, unsigned* tmo_bar) {
    asm volatile("s_waitcnt vmcnt(0)" ::: "memory");
    __syncthreads();
    if (threadIdx.x == 0) {
        asm volatile("" : "+s"(cw));
        (void)xb_add(cw, 1u);
        asm volatile("buffer_inv sc1" ::: "memory");
        XB_SPIN(xb_ld(cw) < target, tmo_bar);
        asm volatile("s_waitcnt vmcnt(0)" ::: "memory");
    }
    __syncthreads();
}

#ifndef FORCE_GLOBAL_BARRIERS
#define FORCE_GLOBAL_BARRIERS 0
#endif
__global__ void __launch_bounds__(NTHREADS, 2) mega(Params P) {
    extern __shared__ __attribute__((aligned(16))) unsigned char lds[];
    const int wv = __builtin_amdgcn_readfirstlane((int)(threadIdx.x >> 6));
    volatile LAS unsigned* xbw = (volatile LAS unsigned*)((LAS unsigned char*)lds + LDS_XB);
    if (threadIdx.x < 4) xbw[threadIdx.x] = 0u;
    __syncthreads();
    const unsigned myx = (unsigned)__builtin_amdgcn_readfirstlane((int)xb_xcc_id());
    if (threadIdx.x == 0) xbw[2] = xb_add((unsigned*)(P.ws + CTL_ROLE) + 64 * myx, 1u);
    const XcdBarrier bar = xcd_barrier_post((unsigned*)(P.ws + CTL_BAR), xbw);
    int vc = blockIdx.x;
    phase_prologue(P, wv, vc, lds);
    xcd_barrier(bar);
    bool uniform = false;
    {
        const unsigned G8 = gridDim.x >> 3; unsigned okc = 0;
#pragma unroll
        for (unsigned j = 0; j < 8; ++j) okc += (xb_ld((unsigned*)(P.ws + CTL_ROLE) + 64 * j) == G8) ? 1u : 0u;
        uniform = !FORCE_GLOBAL_BARRIERS && (gridDim.x & 7u) == 0u && okc == 8u && myx < 8u;
        uniform = __builtin_amdgcn_readfirstlane((int)uniform) != 0;
        if (uniform) vc = (int)(xbw[2] * 8u + myx);
        vc = __builtin_amdgcn_readfirstlane(vc);
    }
    unsigned* lbw = (unsigned*)(P.ws + CTL_LB) + 64 * myx;
    const unsigned nloc = gridDim.x >> 3; unsigned lb_target = 0u;
#define LBAR() do { if (uniform) { lb_target += nloc; xcd_local_barrier(lbw, lb_target, (unsigned*)(P.ws + CTL_BAR)); } else xcd_barrier(bar); } while (0)
#pragma unroll 1
    for (int layer = 0; layer < NLAYER; ++layer) {
        const int jl = layer >> 1;
        const bool pre_first = ((vc & 1) == 0) || !uniform;
        if (pre_first) phase_layer_pre(P, wv, vc, lds, layer);
        if ((layer & 1) == 0) {
            phase_g1_gemm(P, wv, vc, lds, jl, layer); phase_aproj(P, wv, vc, lds, jl, layer);
            LBAR();
            phase_g2_fast(P, wv, vc, lds, jl);
            LBAR();
            phase_g3(P, wv, vc, lds);
            LBAR();
            phase_g4_fast(P, wv, vc, lds, jl);
            LBAR();
            phase_mixout_gemm(P, wv, vc, lds, jl, layer, true);
        } else {
            phase_s1_gemm(P, wv, vc, lds, jl, layer);
            LBAR();
            phase_s2_fast(P, wv, vc, lds, jl);
            LBAR();
            phase_mixout_gemm(P, wv, vc, lds, jl, layer, false);
        }
        if (!pre_first) phase_layer_pre(P, wv, vc, lds, layer);
        LBAR();
        phase_router(P, wv, vc, lds, layer);
        xcd_barrier(bar);
        phase_moe_up(P, wv, vc, lds, layer, MOE_UP_A, uniform);
        LBAR();
        phase_moe_up(P, wv, vc, lds, layer, MOE_UP_B, uniform);
        (void)phase_moe_down(P, wv, vc, lds, layer, MOE_DN_B, uniform);
        LBAR();
        {
            const int nC = phase_moe_down(P, wv, vc, lds, layer, MOE_DN_C, uniform);
            phase_pleup_gemm(P, wv, vc, lds, layer, nC, uniform);
        }
        xcd_barrier(bar);
        phase_ple_gemm(P, wv, vc, lds, layer);
        LBAR();
    }
    phase_final(P, wv, vc);
}

extern "C" void kernel_launch(void* const* d_in, const int* in_sizes, int n_in, void* d_out, int out_size, void* d_ws, size_t ws_size, hipStream_t stream) {
    static int grid = 0;
    if (grid == 0) {
        if (n_in != 26 || ws_size < WS_END) { fprintf(stderr, "kernel_launch: unexpected n_in %d or ws_size %zu\n", n_in, ws_size); grid = -1; return; }
        int dev = 0, cus = 0;
        if (hipGetDevice(&dev) != hipSuccess || hipDeviceGetAttribute(&cus, hipDeviceAttributeMultiprocessorCount, dev) != hipSuccess) { grid = -1; return; }
        if (hipFuncSetAttribute((const void*)mega, hipFuncAttributeMaxDynamicSharedMemorySize, LDS_BYTES) != hipSuccess) { fprintf(stderr, "kernel_launch: hipFuncSetAttribute failed\n"); grid = -1; return; }
        grid = cus < 256 ? cus : 256;
    }
    if (grid < 0) return;
    Params P{};
    for (int i = 0; i < 26; ++i) P.in[i] = (const float*)d_in[i];
    P.out = (float*)d_out; P.ws = (unsigned char*)d_ws;
    (void)hipMemsetAsync((char*)d_ws + CTL_BAR, 0, CTL_CNT + 4 * 32 * CNT_STRIDE * sizeof(int) - CTL_BAR, stream);
    hipLaunchKernelGGL(mega, dim3(grid), dim3(NTHREADS), LDS_BYTES, stream, P);
}
```

```cpp
#include <hip/hip_runtime.h>
#include <stdint.h>
#include <stdio.h>

#define DEVI __device__ __forceinline__
#define LAS __attribute__((address_space(3)))
#ifndef USE_FAST
#define USE_FAST 1
#endif
#ifndef PROBE
#define PROBE 0
#endif
#define PB(k, stmt) do { stmt; if (PROBE == (k)) { __syncthreads(); stmt; } } while (0)
#define XBAR() do { xcd_barrier(bar); if (PROBE == 4) xcd_barrier(bar); } while (0)
typedef unsigned short bf16_t;
typedef short bf16x8 __attribute__((ext_vector_type(8)));
typedef float f32x4 __attribute__((ext_vector_type(4)));
typedef float f32x2 __attribute__((ext_vector_type(2)));
typedef unsigned u32x4 __attribute__((ext_vector_type(4)));
typedef unsigned u32x2 __attribute__((ext_vector_type(2)));

constexpr int T = 16384, D = 1024, SEQ = 2048, NLAYER = 4;
constexpr int GLA_IN = 3088, GLA_Z = 3072, HK = 128, HV = 256, GCH = 64, GNC = 32;
constexpr int SGU_Z = 4096, SGU_W = 2048, SGC = 256, SCH = 128, SNC = 16;
constexpr int NCLS = 24, FF = 512, PLE = 256;
constexpr float EPS = 1e-6f;
constexpr int NTHREADS = 512, NWAVES = 8;

constexpr size_t MiB = 1u << 20;
constexpr size_t WS_CTL = 0, CTL_BYTES = 1 * MiB;
constexpr size_t CTL_PANEL = 102400;
constexpr size_t CTL_CNT = 131072;
constexpr int CNT_STRIDE = 64;
constexpr size_t CTL_BAR = 65536;
constexpr int LDS_STAGE = 0;
constexpr int LDS_SCHED = 131072;
constexpr int LDS_XB = 155632;
constexpr int LDS_BYTES = 155648;
constexpr size_t WS_TOKINFO = 1 * MiB;
constexpr size_t WS_LIST = 2 * MiB;
constexpr size_t WS_AGATE = 4 * MiB;
constexpr size_t WS_BEND = 5 * MiB;
constexpr size_t WS_WR = 6 * MiB;
constexpr size_t WS_SGUWS = 7 * MiB;
constexpr size_t WS_GLA_IN = 8 * MiB;
constexpr size_t WS_GLA_OUT = 21 * MiB;
constexpr size_t WS_SGU_IN = 25 * MiB;
constexpr size_t WS_SGU_OUT = 41 * MiB;
constexpr size_t WS_PLE_GATE = 49 * MiB;
constexpr size_t WS_PLE_UP = 57 * MiB;
constexpr size_t WS_MOE_UP = 60 * MiB;
constexpr size_t WS_MOE_DN = 92 * MiB;
constexpr size_t WS_UPLE = 108 * MiB;
constexpr size_t WS_HB0 = 172 * MiB;
constexpr size_t WS_HB1 = 204 * MiB;
constexpr size_t WS_ZBUF = 236 * MiB;
constexpr size_t WS_BUF2 = 364 * MiB;
constexpr size_t WS_PB = 428 * MiB;
constexpr size_t WS_SSQP = 436 * MiB;
constexpr size_t WS_LNP = 444 * MiB;
constexpr size_t WS_END = 452 * MiB;
constexpr size_t ZB_OB = (size_t)T * GLA_Z * 2;
constexpr size_t ZB_UPLE = 48 * MiB;
constexpr int ACT_ROWS = 88 * 256;

struct Params {
    const float* in[26];
    float* out;
    unsigned char* ws;
};
enum { I_X = 0, I_P, I_GLA_WIN, I_GLA_WGU, I_GLA_BG, I_GLA_GH, I_GLA_WOUT, I_SGU_WIN, I_SGU_LNG, I_SGU_LNB, I_SGU_WS, I_SGU_BS, I_SGU_WOUT,
       I_NMIX, I_NFFN, I_NPLE, I_WRG, I_BRG, I_WRE, I_BRE, I_MOE_WG, I_MOE_WU, I_MOE_WD, I_PLE_WUP, I_PLE_WG, I_FINAL };

DEVI int opaque_tid_(int wv) { int l; asm volatile("v_mbcnt_lo_u32_b32 %0, -1, 0\n\tv_mbcnt_hi_u32_b32 %0, -1, %0" : "=v"(l)); return (wv << 6) | l; }
#define opaque_tid() opaque_tid_(wv)
DEVI unsigned f2bf(float f) { unsigned u = __float_as_uint(f); return (u + 0x7fffu + ((u >> 16) & 1u)) >> 16; }
DEVI float bf2f(unsigned b) { return __uint_as_float(b << 16); }
DEVI unsigned pk2(float lo, float hi) { return f2bf(lo) | (f2bf(hi) << 16); }
DEVI float bflo(unsigned w) { return __uint_as_float(w << 16); }
DEVI float bfhi(unsigned w) { return __uint_as_float(w & 0xffff0000u); }
DEVI float wave_sum(float v) {
#pragma unroll
    for (int o = 1; o < 64; o <<= 1) v += __shfl_xor(v, o);
    return v;
}
DEVI float sigmoidf_(float x) { return __builtin_amdgcn_rcpf(1.0f + __expf(-x)); }
DEVI float siluf_(float x) { return x * sigmoidf_(x); }
DEVI float gelu_tanh(float x) {
    const float y = 0.7978845608028654f * (x + 0.044715f * x * x * x);
    return x * __builtin_amdgcn_rcpf(1.0f + __expf(-2.0f * y));
}
DEVI float logsigmoidf_(float x) { return fminf(x, 0.0f) - __logf(1.0f + __expf(-fabsf(x))); }
DEVI float rstd_from_ssq(float ssq) { return rsqrtf(ssq * (1.0f / D) + EPS); }
DEVI float rstd16s(const float* ssq, int row) {
    float v[16];
#pragma unroll
    for (int k = 0; k < 16; ++k) v[k] = ssq[(size_t)k * T + row];
    const float s = (((v[0] + v[1]) + (v[2] + v[3])) + ((v[4] + v[5]) + (v[6] + v[7]))) + (((v[8] + v[9]) + (v[10] + v[11])) + ((v[12] + v[13]) + (v[14] + v[15])));
    return rstd_from_ssq(s);
}
DEVI float rstd16(const float* p) {
    const f32x4 a = *(const f32x4*)p, b = *(const f32x4*)(p + 4), c = *(const f32x4*)(p + 8), d = *(const f32x4*)(p + 12);
    const float s = ((a.x + a.y) + (a.z + a.w)) + ((b.x + b.y) + (b.z + b.w)) + ((c.x + c.y) + (c.z + c.w)) + ((d.x + d.y) + (d.z + d.w));
    return rstd_from_ssq(s);
}

DEVI void tr_item(const float* W, int K, int N, const float* gain, bf16_t* WT, int k0, int n0, int nvalid, int rowbase, float* scr, int lane) {
    const int n = lane & 31, hi = lane >> 5;
    float v[32];
    const float gv = gain ? gain[k0 + lane] : 1.0f;
    const float* src = W + (size_t)(k0 + hi) * N + n0 + n;
#pragma unroll
    for (int i = 0; i < 32; ++i) v[i] = (n < nvalid) ? src[(size_t)(2 * i) * N] : 0.f;
#pragma unroll
    for (int i = 0; i < 32; ++i) scr[(2 * i + hi) * 33 + n] = v[i] * __shfl(gv, 2 * i + hi);
    asm volatile("s_waitcnt lgkmcnt(0)" ::: "memory");
    const int c = lane & 7;
#pragma unroll
    for (int j = 0; j < 4; ++j) {
        const int nn = (lane >> 3) + 8 * j; const float* sp = scr + (8 * c) * 33 + nn;
        u32x4 o; o.x = pk2(sp[0 * 33], sp[1 * 33]); o.y = pk2(sp[2 * 33], sp[3 * 33]); o.z = pk2(sp[4 * 33], sp[5 * 33]); o.w = pk2(sp[6 * 33], sp[7 * 33]);
        if (nn < nvalid) *(u32x4*)(WT + (size_t)(rowbase + nn) * K + k0 + 8 * c) = o;
    }
    asm volatile("s_waitcnt lgkmcnt(0)" ::: "memory");
}
DEVI void conv_mat(const float* W, int K, int N, const float* gain, bf16_t* WT, int mode, int& off, int gw, int ngw, float* scr, int lane) {
    const int nnb = (N + 31) / 32, nitems = (K / 64) * nnb;
    const int first = gw - off < 0 ? gw - off + ngw : gw - off;
    for (int it = first; it < nitems; it += ngw) {
        const int kb = it / nnb, nb = it % nnb, n0 = 32 * nb, nvalid = (N - n0) < 32 ? (N - n0) : 32;
        const int rowbase = mode == 0 ? n0 : ((n0 >> 7) * 256 + (n0 & 127) + (mode == 2 ? 128 : 0));
        tr_item(W, K, N, gain, WT, 64 * kb, n0, nvalid, rowbase, scr, lane);
    }
    off += nitems; while (off >= ngw) off -= ngw;
}

struct CvDesc { const float* W; const float* gain; bf16_t* WT; int K, N, k0, n0, nvalid, rowbase; };
DEVI bool cv_decode(const Params& P, int layer, int id, CvDesc& d) {
    unsigned char* ws = P.ws;
    const float* W; const float* gain = nullptr; bf16_t* WT; int K, N, mode = 0, it, sh;
    if (layer < 0) {
        if (id < 1552) { it = id; W = P.in[I_GLA_WIN]; gain = P.in[I_NMIX]; WT = (bf16_t*)(ws + WS_GLA_IN); K = D; N = GLA_IN; sh = 0; }
        else if (id < 2064) { it = id - 1552; W = P.in[I_GLA_WOUT]; WT = (bf16_t*)(ws + WS_GLA_OUT); K = D; N = D; sh = 5; }
        else return false;
    } else if (id < 12288) {
        const int e = id / 768, r = id - e * 768, kind = r >> 8; it = r & 255;
        if (kind < 2) { W = (kind == 0 ? P.in[I_MOE_WG] : P.in[I_MOE_WU]) + ((size_t)layer * 16 + e) * D * FF; gain = P.in[I_NFFN] + layer * D; WT = (bf16_t*)(ws + WS_MOE_UP) + (size_t)e * 1024 * 1024; K = D; N = FF; mode = 1 + kind; sh = 4; }
        else { W = P.in[I_MOE_WD] + ((size_t)layer * 16 + e) * FF * D; WT = (bf16_t*)(ws + WS_MOE_DN) + (size_t)e * 1024 * 512; K = FF; N = D; sh = 5; }
    } else if (id < 12800) { it = id - 12288; W = P.in[I_PLE_WG] + (size_t)layer * D * D; gain = P.in[I_NPLE] + layer * D; WT = (bf16_t*)(ws + WS_PLE_GATE) + (size_t)layer * D * D; K = D; N = D; sh = 5; }
    else if (id < 12928) { it = id - 12800; W = P.in[I_PLE_WUP] + (size_t)layer * PLE * D; WT = (bf16_t*)(ws + WS_PLE_UP) + (size_t)layer * D * PLE; K = PLE; N = D; sh = 5; }
    else {
        const int nl = layer + 1, j = nl >> 1, r = id - 12928;
        if (nl >= NLAYER) return false;
        if ((nl & 1) == 0) {
            if (r < 1552) { it = r; W = P.in[I_GLA_WIN] + (size_t)j * D * GLA_IN; gain = P.in[I_NMIX] + nl * D; WT = (bf16_t*)(ws + WS_GLA_IN) + (size_t)j * GLA_IN * D; K = D; N = GLA_IN; sh = 0; }
            else if (r < 2064) { it = r - 1552; W = P.in[I_GLA_WOUT] + (size_t)j * D * D; WT = (bf16_t*)(ws + WS_GLA_OUT) + (size_t)j * D * D; K = D; N = D; sh = 5; }
            else return false;
        } else {
            if (r < 2048) { it = r; W = P.in[I_SGU_WIN] + (size_t)j * D * SGU_Z; gain = P.in[I_NMIX] + nl * D; WT = (bf16_t*)(ws + WS_SGU_IN) + (size_t)j * SGU_Z * D; K = D; N = SGU_Z; sh = 7; }
            else if (r < 3072) { it = r - 2048; W = P.in[I_SGU_WOUT] + (size_t)j * SGU_W * D; WT = (bf16_t*)(ws + WS_SGU_OUT) + (size_t)j * D * SGU_W; K = SGU_W; N = D; sh = 5; }
            else return false;
        }
    }
    const int kb = sh ? (it >> sh) : it / 97, nb = it - kb * (sh ? (1 << sh) : 97), n0 = 32 * nb;
    d.W = W; d.gain = gain; d.WT = WT; d.K = K; d.N = N; d.k0 = 64 * kb; d.n0 = n0; d.nvalid = (N - n0) < 32 ? (N - n0) : 32;
    d.rowbase = mode == 0 ? n0 : ((n0 >> 7) * 256 + (n0 & 127) + (mode == 2 ? 128 : 0));
    return true;
}
DEVI void cv_load(const CvDesc& d, float (&v)[32], float& gv, int lane) {
    const int n = lane & 31, hi = lane >> 5;
    gv = d.gain ? d.gain[d.k0 + lane] : 1.0f;
    const float* src = d.W + (size_t)(d.k0 + hi) * d.N + d.n0 + (n < d.nvalid ? n : d.nvalid - 1);
#pragma unroll
    for (int i = 0; i < 32; ++i) v[i] = src[(size_t)(2 * i) * d.N];
}
DEVI void cv_store(const CvDesc& d, const float (&v)[32], float gv, float* scr, int lane) {
    const int n = lane & 31, hi = lane >> 5;
#pragma unroll
    for (int i = 0; i < 32; ++i) scr[(2 * i + hi) * 33 + n] = v[i] * __shfl(gv, 2 * i + hi);
    asm volatile("s_waitcnt lgkmcnt(0)" ::: "memory");
    const int c = lane & 7;
#pragma unroll
    for (int j = 0; j < 4; ++j) {
        const int nn = (lane >> 3) + 8 * j; const float* sp = scr + (8 * c) * 33 + nn;
        u32x4 o; o.x = pk2(sp[0 * 33], sp[1 * 33]); o.y = pk2(sp[2 * 33], sp[3 * 33]); o.z = pk2(sp[4 * 33], sp[5 * 33]); o.w = pk2(sp[6 * 33], sp[7 * 33]);
        if (nn < d.nvalid) *(u32x4*)(d.WT + (size_t)(d.rowbase + nn) * d.K + d.k0 + 8 * c) = o;
    }
    asm volatile("s_waitcnt lgkmcnt(0)" ::: "memory");
}
DEVI void cv_run(const Params& P, int layer, int gw, int ngw, float* scr, int lane, int id_end = 0x7fffffff) {
    CvDesc da, db; float va[32], vb[32], ga = 1.0f, gb = 1.0f;
    int id = gw;
    bool ha = id < id_end && cv_decode(P, layer, id, da);
    if (ha) cv_load(da, va, ga, lane);
    while (ha) {
        id += ngw; const bool hb = id < id_end && cv_decode(P, layer, id, db); if (hb) cv_load(db, vb, gb, lane);
        cv_store(da, va, ga, scr, lane);
        if (!hb) break;
        id += ngw; ha = id < id_end && cv_decode(P, layer, id, da); if (ha) cv_load(da, va, ga, lane);
        cv_store(db, vb, gb, scr, lane);
    }
}

DEVI void phase_prologue(const Params& P, int wv, int vc, unsigned char* lds) {
    const int tid = opaque_tid(), lane = tid & 63, wave = wv;
    const int gw = vc * NWAVES + wave, ngw = gridDim.x * NWAVES;
    float* scr = (float*)(lds + wave * 8704);
    unsigned char* ws = P.ws;
    const float* x = P.in[I_X]; f32x4 v[8][4];
#pragma unroll
    for (int q = 0; q < 4; ++q) { const int row = gw + q * ngw; const f32x4* xr = (const f32x4*)(x + (size_t)(row < T ? row : 0) * D) + lane;
#pragma unroll
        for (int j = 0; j < 4; ++j) v[q][j] = xr[64 * j]; }
    cv_run(P, -1, gw, ngw, scr, lane);
    {
        const float* src = P.in[I_SGU_WS]; bf16_t* dst = (bf16_t*)(ws + WS_SGUWS);
        for (int idx = vc * NTHREADS + tid; idx < 2 * 8 * 128 * 128; idx += gridDim.x * NTHREADS) {
            const int s = idx & 127, t = (idx >> 7) & 127;
            dst[idx] = (bf16_t)f2bf(s <= t ? src[idx] : 0.f);
        }
    }
    {
        bf16_t* wr = (bf16_t*)(ws + WS_WR);
        for (int idx = vc * NTHREADS + tid; idx < NLAYER * 32 * D; idx += gridDim.x * NTHREADS) {
            const int k = idx % D, o = (idx / D) % 32, l = idx / (32 * D);
            float w = 0.f;
            if (o < 20) { const float g = P.in[I_NFFN][l * D + k]; w = g * ((o < 4) ? P.in[I_WRG][((size_t)l * D + k) * 4 + o] : P.in[I_WRE][((size_t)l * D + k) * 16 + (o - 4)]); }
            const unsigned hi = f2bf(w); const unsigned lo = f2bf(w - bf2f(hi));
            wr[((size_t)(l * 2 + 0) * 32 + o) * D + k] = (bf16_t)hi; wr[((size_t)(l * 2 + 1) * 32 + o) * D + k] = (bf16_t)lo;
        }
    }
    {
        bf16_t* hb0 = (bf16_t*)(ws + WS_HB0); float* ssq = (float*)(ws + WS_SSQP);
        for (int row0 = gw; row0 < T; row0 += 8 * ngw) {
#pragma unroll
            for (int q = 4; q < 8; ++q) { const int row = row0 + q * ngw; const f32x4* xr = (const f32x4*)(x + (size_t)(row < T ? row : 0) * D) + lane;
#pragma unroll
                for (int j = 0; j < 4; ++j) v[q][j] = xr[64 * j]; }
            if (row0 != gw) {
#pragma unroll
                for (int q = 0; q < 4; ++q) { const int row = row0 + q * ngw; const f32x4* xr = (const f32x4*)(x + (size_t)(row < T ? row : 0) * D) + lane;
#pragma unroll
                    for (int j = 0; j < 4; ++j) v[q][j] = xr[64 * j]; }
            }
#pragma unroll
            for (int q = 0; q < 8; ++q) {
                const int row = row0 + q * ngw; if (row < T) {
                float s = 0.f;
#pragma unroll
                for (int j = 0; j < 4; ++j) {
                    const f32x4 w = v[q][j];
                    s += w.x * w.x + w.y * w.y + w.z * w.z + w.w * w.w;
                    u32x2 o; o.x = pk2(w.x, w.y); o.y = pk2(w.z, w.w);
                    *(u32x2*)(hb0 + (size_t)row * D + 4 * lane + 256 * j) = o;
                }
                s = wave_sum(s);
                if (lane < 16) ssq[(size_t)lane * T + row] = lane == 0 ? s : 0.f;
                }
            }
        }
    }
}

DEVI void phase_layer_pre(const Params& P, int wv, int vc, unsigned char* lds, int layer, bool uniform) {
    const int tid = opaque_tid(), lane = tid & 63, wave = wv;
    const int gw = vc * NWAVES + wave, ngw = gridDim.x * NWAVES;
    float* scr = (float*)(lds + wave * 8704);
    unsigned char* ws = P.ws;
    int id0 = gw, step = ngw, id_end = 0x7fffffff;
    if (uniform && gridDim.x == 256) {
        const int g = vc & 7, ip = ((g >> 1) * 32 + (vc >> 3)) * NWAVES + wave;
        const int ce = layer == NLAYER - 1 ? 7 : 9;
        step = 1024;
        if ((g & 1) == 0) { id0 = ip; id_end = 1024 * ce; } else id0 = 1024 * ce + ip;
    }
    cv_run(P, layer, id0, step, scr, lane, id_end);
    const float* p = P.in[I_P] + (size_t)layer * T * PLE; bf16_t* pb = (bf16_t*)(ws + WS_PB);
    {
        const size_t stride = (size_t)gridDim.x * NTHREADS, i0 = (size_t)vc * NTHREADS + tid, nq = (size_t)T * PLE / 4;
        for (size_t base = i0; base < nq; base += 8 * stride) {
            f32x4 v[8];
#pragma unroll
            for (int j = 0; j < 8; ++j) { const size_t idx = base + j * stride; v[j] = idx < nq ? ((const f32x4*)p)[idx] : (f32x4){0.f, 0.f, 0.f, 0.f}; }
#pragma unroll
            for (int j = 0; j < 8; ++j) { const size_t idx = base + j * stride; if (idx < nq) { u32x2 o; o.x = pk2(v[j].x, v[j].y); o.y = pk2(v[j].z, v[j].w); ((u32x2*)pb)[idx] = o; } }
        }
    }
}

struct Unit {
    int pm, pn;
    const bf16_t* A;
    const LAS int* rows;
    int nvalid;
    const bf16_t* B0;
    const bf16_t* B1;
    int aux0, aux1;
    int idx;
};
struct GemmShape { int lda, ldb, K, ksplit; bool gatherA; };
constexpr int NXCD = 8, WGM = 8;
struct PlainSched {
    const bf16_t* A; const bf16_t* Bt; int lda, ldb; int nM, nN, nwg, G, c;
    DEVI void init(const bf16_t* A_, int lda_, const bf16_t* Bt_, int ldb_, int M, int N, int G_, int c_) { A = A_; Bt = Bt_; lda = lda_; ldb = ldb_; nM = M / 256; nN = N / 256; nwg = nM * nN; G = G_; c = c_; }
    DEVI bool next(int i, Unit& u) const {
        const long L = (long)i * G + c; if (L >= nwg) return false;
        int wgid = (int)L; { const int q = nwg / NXCD, r = nwg % NXCD, xcd = wgid % NXCD, off = wgid / NXCD; wgid = (xcd < r ? xcd * (q + 1) : r * (q + 1) + (xcd - r) * q) + off; }
        const int nig = WGM * nN, gid = wgid / nig, fm = gid * WGM, gsz = (nM - fm) < WGM ? (nM - fm) : WGM;
        u.pm = fm + ((wgid % nig) % gsz); u.pn = (wgid % nig) / gsz;
        u.A = A + (size_t)u.pm * 256 * lda; u.rows = nullptr; u.nvalid = 256; u.B0 = Bt + (size_t)u.pn * 256 * ldb; u.B1 = u.B0; u.aux0 = 0; u.aux1 = 0; u.idx = i;
        return true;
    }
};
constexpr int LDS_RTAB = LDS_SCHED + 8192;
struct NoHook { DEVI void operator()() const {} };
template <class Sched> struct RstdHook {
    int wv; unsigned char* lds; const Sched* S; const float* ssq;
    DEVI void operator()() const {
        const int tid = opaque_tid();
        LAS float* rtab = (LAS float*)((LAS unsigned char*)lds + LDS_RTAB);
        const int half = __builtin_amdgcn_readfirstlane(tid >> 8), r = tid & 255;
        float v[2]; bool ok[2];
#pragma unroll
        for (int i2 = 0; i2 < 2; ++i2) { Unit u; ok[i2] = S->next(2 * i2 + half, u); v[i2] = ok[i2] ? rstd16s(ssq, u.pm * 256 + r) : 0.f; }
#pragma unroll
        for (int i2 = 0; i2 < 2; ++i2) if (ok[i2]) rtab[(2 * i2 + half) * 256 + r] = v[i2];
    }
};
template <class Sched> DEVI void rstd_table_setup(int wv, unsigned char* lds, const Sched& S, const float* ssq) {
    const int tid = opaque_tid();
    LAS float* rtab = (LAS float*)((LAS unsigned char*)lds + LDS_RTAB);
    __syncthreads();
    const int half = __builtin_amdgcn_readfirstlane(tid >> 8), r = tid & 255;
    float v[2]; bool ok[2];
#pragma unroll
    for (int i2 = 0; i2 < 2; ++i2) { Unit u; ok[i2] = S.next(2 * i2 + half, u); v[i2] = ok[i2] ? rstd16s(ssq, u.pm * 256 + r) : 0.f; }
#pragma unroll
    for (int i2 = 0; i2 < 2; ++i2) if (ok[i2]) rtab[(2 * i2 + half) * 256 + r] = v[i2];
    __syncthreads();
}
DEVI void cls_experts(int cl, int& e1, int& e2) { const int g = cl / 6, p = cl % 6; const int a = p < 3 ? 0 : (p < 5 ? 1 : 2); const int b = p < 3 ? p + 1 : (p < 5 ? p - 1 : 3); e1 = g * 4 + a; e2 = g * 4 + b; }
DEVI int moe_find_cls(const LAS int* pre, int rt) { int cl = 0;
#pragma unroll 1
    for (int k = 1; k < NCLS; ++k) if (pre[k] <= rt) cl = k;
    return cl; }
struct MoeSched {
    const LAS int* pre; const LAS int* cnt; const LAS int* rowsl; int ncol, G, c; bool up; const bf16_t* A; const bf16_t* W;
    DEVI bool next(int i, Unit& u) const {
        if (i >= 4) return false;
        const LAS int* ud = pre + 1088 + 4 * i;
        const int rt = ud[0]; if (rt < 0) return false;
        const int pn = ud[1], cl = ud[2];
        u.pm = rt; u.pn = pn; u.rows = rowsl + i * 256; u.nvalid = ud[3]; u.idx = i;
        int e1, e2; cls_experts(cl, e1, e2);
        if (up) { const int which = pn >> 2; const int e = which ? e2 : e1; u.A = A; u.B0 = W + ((size_t)e * 1024 + (pn & 3) * 256) * 1024; u.B1 = u.B0; u.aux0 = rt * 256; u.aux1 = which; }
        else { u.A = A + (size_t)rt * 256 * 1024; u.B0 = W + ((size_t)e1 * 1024 + pn * 256) * 512; u.B1 = W + ((size_t)e2 * 1024 + pn * 256) * 512; u.aux0 = rt * 256; u.aux1 = 0; }
        return true;
    }
};
enum { MOE_UP_A = 0, MOE_UP_B, MOE_DN_B, MOE_DN_C };
DEVI int moe_sched_setup(const Params& P, int wv, int vc, int layer, LAS int* lds_pre, LAS int* lds_cnt, LAS int* rowsl, int ncol, int mode, bool grp) {
    const int* cnt = (const int*)(P.ws + CTL_CNT) + layer * 32 * CNT_STRIDE; const int* list = (const int*)(P.ws + WS_LIST);
    const int tid = opaque_tid();
    __syncthreads();
    if (mode == MOE_UP_A && tid < 32) {
        const int n = tid < NCLS ? cnt[tid * CNT_STRIDE] : 0; const int tl = (n + 255) >> 8; int x = tl;
#pragma unroll
        for (int o = 1; o < 32; o <<= 1) { const int y = __shfl_up(x, o); if (tid >= o) x += y; }
        if (tid < NCLS) { lds_cnt[tid] = n; lds_pre[tid] = x - tl; }
        if (tid == NCLS - 1) lds_pre[NCLS] = x;
    }
    __syncthreads();
    int ntile = lds_pre[NCLS], G = (int)gridDim.x, c = vc, rt0 = 0;
    if (grp) { const int x = vc & 7, q = ntile >> 3, rem = ntile & 7; G >>= 3; c = vc >> 3; rt0 = x * q + (x < rem ? x : rem); ntile = q + (x < rem ? 1 : 0); }
    const int n2 = 8 * ntile, n3 = 4 * ntile;
    const int nA = n2 < 2 * G ? n2 : 2 * G, nB = n2 - nA;
    const int wB = nB < G ? nB : G;
    const int dB = (G - wB) < n3 ? (G - wB) : n3;
    int L0, N, c_off, Gx;
    if (mode == MOE_UP_A) { L0 = 0; N = nA; c_off = 0; Gx = G; }
    else if (mode == MOE_UP_B) { L0 = nA; N = nB; c_off = 0; Gx = wB > 0 ? wB : 1; }
    else if (mode == MOE_DN_B) { L0 = 0; N = dB; c_off = wB; Gx = (G - wB) > 0 ? (G - wB) : 1; }
    else { L0 = dB; N = n3 - dB; c_off = 0; Gx = G; }
    const int my = c - c_off;
    const int lane = tid & 63;
    const int pre_l = lds_pre[lane < NCLS ? lane : NCLS];
    int cl_[4], tt_[4], nv_[4]; bool ok_[4];
#pragma unroll
    for (int i = 0; i < 4; ++i) {
        const int L = L0 + my + i * Gx;
        ok_[i] = !(my < 0 || my >= Gx || L >= L0 + N);
        const int rt = rt0 + (ok_[i] ? L / ncol : 0);
        const unsigned long long m = __ballot(lane < NCLS && pre_l <= rt);
        const int cl = __popcll(m) - 1;
        const int tt = rt - lds_pre[cl]; int nv = lds_cnt[cl] - 256 * tt; nv = nv < 256 ? nv : 256;
        cl_[i] = cl; tt_[i] = tt; nv_[i] = nv;
        if (tid == 0) { lds_pre[1088 + 4 * i] = ok_[i] ? rt : -1; lds_pre[1089 + 4 * i] = L % ncol; lds_pre[1090 + 4 * i] = cl; lds_pre[1091 + 4 * i] = nv; }
    }
    (void)tt_; (void)list; (void)rowsl;
    __syncthreads();
    return N;
}
struct MoeListHook {
    int wv; const LAS int* pre; const LAS int* cnt_; LAS int* rowsl; const int* list; bool sync;
    DEVI void operator()() const {
        const int tid = opaque_tid(), hsel = __builtin_amdgcn_readfirstlane(tid >> 8), r = tid & 255; int v[2];
#pragma unroll
        for (int i2 = 0; i2 < 2; ++i2) {
            const LAS int* ud = pre + 1088 + 4 * (2 * i2 + hsel);
            const int rt = ud[0], cl = ud[2], nv = ud[3]; const bool ok = rt >= 0;
            const int tt = rt - pre[ok ? cl : 0];
            v[i2] = ok ? list[(size_t)cl * T + 256 * tt + (r < nv ? r : nv - 1)] : 0;
        }
#pragma unroll
        for (int i2 = 0; i2 < 2; ++i2) rowsl[(2 * i2 + hsel) * 256 + r] = v[i2];
        if (sync) __syncthreads();
    }
};

DEVI int perm32(int rho) { const int n = rho >> 4, i = rho & 15; return 8 * (i >> 2) + 4 * n + (i & 3); }
DEVI int unit_row(const Unit& u, int r) { return u.rows ? u.rows[r] : u.pm * 256 + r; }
DEVI bool unit_valid(const Unit& u, int r) { return !u.rows || r < u.nvalid; }

typedef __bf16 bf16x2_t __attribute__((ext_vector_type(2)));
DEVI unsigned pk4_fp8(float a, float b, float c, float d) {
    a = __builtin_amdgcn_fmed3f(a, -224.f, 224.f); b = __builtin_amdgcn_fmed3f(b, -224.f, 224.f); c = __builtin_amdgcn_fmed3f(c, -224.f, 224.f); d = __builtin_amdgcn_fmed3f(d, -224.f, 224.f);
    int w = 0; w = __builtin_amdgcn_cvt_pk_fp8_f32(a, b, w, false); w = __builtin_amdgcn_cvt_pk_fp8_f32(c, d, w, true); return (unsigned)w;
}
DEVI f32x2 fp8lo2(unsigned w) { return __builtin_amdgcn_cvt_pk_f32_fp8((int)w, false); }
DEVI f32x2 fp8hi2(unsigned w) { return __builtin_amdgcn_cvt_pk_f32_fp8((int)w, true); }
DEVI unsigned cvt_pk_bf16(float lo, float hi) { const bf16x2_t v = __builtin_convertvector((f32x2){lo, hi}, bf16x2_t); return __builtin_bit_cast(unsigned, v); }

DEVI f32x2 gelu_tanh2(f32x2 x) {
    const f32x2 x2 = x * x;
    const f32x2 t = x * (x2 * (-2.0f * 1.4426950408889634f * 0.7978845608028654f * 0.044715f) + (-2.0f * 1.4426950408889634f * 0.7978845608028654f));
    f32x2 e; e.x = __builtin_amdgcn_exp2f(t.x); e.y = __builtin_amdgcn_exp2f(t.y);
    const f32x2 d = e + 1.0f;
    f32x2 r; r.x = __builtin_amdgcn_rcpf(d.x); r.y = __builtin_amdgcn_rcpf(d.y);
    return x * r;
}
DEVI f32x2 sigmoid2(f32x2 x) {
    const f32x2 t = x * (-1.4426950408889634f);
    f32x2 e; e.x = __builtin_amdgcn_exp2f(t.x); e.y = __builtin_amdgcn_exp2f(t.y);
    const f32x2 d = e + 1.0f;
    f32x2 r; r.x = __builtin_amdgcn_rcpf(d.x); r.y = __builtin_amdgcn_rcpf(d.y);
    return r;
}
DEVI u32x4 xchg8(u32x4 v) { u32x4 r; r.x = __shfl_xor(v.x, 8); r.y = __shfl_xor(v.y, 8); r.z = __shfl_xor(v.z, 8); r.w = __shfl_xor(v.w, 8); return r; }
DEVI u32x4 sel4(bool c, u32x4 a, u32x4 b) { u32x4 r; r.x = c ? a.x : b.x; r.y = c ? a.y : b.y; r.z = c ? a.z : b.z; r.w = c ? a.w : b.w; return r; }
template <bool F8>
struct EpiZT {
    static constexpr bool PERM = true, CMAP = true;
    bf16_t* O; int ldc; const LAS float* ssq; int act; float* lnstat; int stat_pn0;
    DEVI void operator()(const f32x4 (&acc)[2][2][4][2], const Unit& u, int wr, int wc, int fr, int fq) const {
        const bool st = act == 1 && u.pn >= stat_pn0;
        const bool lo = fr < 8;
        const int colx = u.pn * 256 + 64 * wc + (lo ? 0 : 32) + 8 * fq;
#pragma unroll
        for (int ai = 0; ai < 2; ++ai)
#pragma unroll
            for (int m = 0; m < 4; ++m) {
                const int rloc = ai * 128 + wr * 64 + m * 16;
                const int row = u.pm * 256 + rloc + fr;
                const float rs = ssq ? ssq[u.idx * 256 + rloc + fr] : 1.0f;
                f32x2 sv1 = (f32x2){0.f, 0.f}, sv2 = (f32x2){0.f, 0.f};
                u32x4 Pz[2]; f32x2 Pf[2][4];
#pragma unroll
                for (int bj = 0; bj < 2; ++bj) {
                    f32x2 v2[4];
#pragma unroll
                    for (int n = 0; n < 2; ++n)
#pragma unroll
                        for (int e = 0; e < 2; ++e) {
                            f32x2 x = (f32x2){acc[ai][bj][m][n][2 * e], acc[ai][bj][m][n][2 * e + 1]} * rs;
                            if (st) x = gelu_tanh2(x);
                            v2[2 * n + e] = x; if (st) { sv1 += x; sv2 += x * x; }
                        }
                    Pz[bj].x = cvt_pk_bf16(v2[0].x, v2[0].y); Pz[bj].y = cvt_pk_bf16(v2[1].x, v2[1].y); Pz[bj].z = cvt_pk_bf16(v2[2].x, v2[2].y); Pz[bj].w = cvt_pk_bf16(v2[3].x, v2[3].y);
#pragma unroll
                    for (int q4 = 0; q4 < 4; ++q4) Pf[bj][q4] = v2[q4];
                }
                if (F8) {
                    u32x2 P8[2];
#pragma unroll
                    for (int bj = 0; bj < 2; ++bj) { P8[bj].x = pk4_fp8(Pf[bj][0].x, Pf[bj][0].y, Pf[bj][1].x, Pf[bj][1].y); P8[bj].y = pk4_fp8(Pf[bj][2].x, Pf[bj][2].y, Pf[bj][3].x, Pf[bj][3].y); }
                    const bool ev = (fq & 1) == 0;
                    const u32x2 snd = ev ? P8[1] : P8[0];
                    u32x2 rc; rc.x = __shfl_xor(snd.x, 16); rc.y = __shfl_xor(snd.y, 16);
                    const u32x4 o16 = ev ? (u32x4){P8[0].x, P8[0].y, rc.x, rc.y} : (u32x4){rc.x, rc.y, P8[1].x, P8[1].y};
                    const int col8 = u.pn * 256 + 64 * wc + (ev ? 0 : 32) + 16 * (fq >> 1);
                    *(u32x4*)((unsigned char*)O + (size_t)row * ldc + col8) = o16;
                } else {
                const u32x4 rcv = xchg8(sel4(lo, Pz[1], Pz[0]));
                const size_t rowA = (size_t)(u.pm * 256 + rloc + (fr & 7));
                *(u32x4*)(O + rowA * ldc + colx) = sel4(lo, Pz[0], rcv);
                *(u32x4*)(O + (rowA + 8) * ldc + colx) = sel4(lo, rcv, Pz[1]);
                }
                if (st) {
                    float s1 = sv1.x + sv1.y, s2 = sv2.x + sv2.y;
                    s1 += __shfl_xor(s1, 16); s1 += __shfl_xor(s1, 32); s2 += __shfl_xor(s2, 16); s2 += __shfl_xor(s2, 32);
                    if (fq == 0) *(f32x2*)(lnstat + ((size_t)row * 32 + (u.pn - stat_pn0) * 4 + wc) * 2) = (f32x2){s1, s2};
                }
            }
    }
};
typedef EpiZT<false> EpiZ;
struct EpiAct {
    static constexpr bool PERM = true, CMAP = false;
    bf16_t* act; const f32x4* tokinfo;
    DEVI void operator()(const f32x4 (&acc)[2][2][4][2], const Unit& u, int wr, int wc, int fr, int fq) const {
        f32x4 infos[8];
#pragma unroll
        for (int it = 0; it < 8; ++it) infos[it] = tokinfo[unit_row(u, (it >> 2) * 128 + wr * 64 + (it & 3) * 16 + fr)];
#pragma unroll
        for (int ai = 0; ai < 2; ++ai)
#pragma unroll
            for (int m = 0; m < 4; ++m) {
                const int r = ai * 128 + wr * 64 + m * 16 + fr;
                const f32x4 info = infos[ai * 4 + m];
                const float rs = info.x, w = u.aux1 ? info.z : info.y;
                f32x2 v2[4]; const float rsw = rs * w;
#pragma unroll
                for (int n = 0; n < 2; ++n)
#pragma unroll
                    for (int e = 0; e < 2; ++e) {
                        const f32x2 g = (f32x2){acc[ai][0][m][n][2 * e], acc[ai][0][m][n][2 * e + 1]} * rs, up = (f32x2){acc[ai][1][m][n][2 * e], acc[ai][1][m][n][2 * e + 1]} * rsw;
                        v2[2 * n + e] = g * sigmoid2(g) * up;
                    }
                u32x4 o; o.x = cvt_pk_bf16(v2[0].x, v2[0].y); o.y = cvt_pk_bf16(v2[1].x, v2[1].y); o.z = cvt_pk_bf16(v2[2].x, v2[2].y); o.w = cvt_pk_bf16(v2[3].x, v2[3].y);
                *(u32x4*)(act + (size_t)(u.aux0 + r) * 1024 + u.aux1 * 512 + (u.pn & 3) * 128 + wc * 32 + 8 * fq) = o;
            }
    }
};
template <bool UP>
struct EpiRes {
    static constexpr bool PERM = true, CMAP = true;
    static constexpr int NB = UP ? 2 : 4;
    const bf16_t* hin; bf16_t* hout; float* ssq_out; const bf16_t* uple; const LAS float* ssq_in;
    DEVI void operator()(const f32x4 (&acc)[2][2][4][2], const Unit& u, int wr, int wc, int fr, int fq) const {
        asm volatile("" : "+v"(fr), "+v"(fq));
        const bool lo = fr < 8;
        const int colx = u.pn * 256 + 64 * wc + (lo ? 0 : 32) + 8 * fq;
        u32x4 hb[NB][2], ub[UP ? NB : 1][2];
#pragma unroll
        for (int it = 0; it < NB; ++it) {
            const int rA = (it >> 2) * 128 + wr * 64 + (it & 3) * 16 + (fr & 7);
            const size_t offA = (size_t)unit_row(u, rA) * D + colx, offB = (size_t)unit_row(u, rA + 8) * D + colx;
            hb[it][0] = *(const u32x4*)(hin + offA); hb[it][1] = *(const u32x4*)(hin + offB);
            if (UP) { ub[it][0] = *(const u32x4*)(uple + offA); ub[it][1] = *(const u32x4*)(uple + offB); }
        }
#pragma unroll
        for (int it = 0; it < 8; ++it) {
            const int ai = it >> 2, m = it & 3, sl = it % NB;
            const int rloc = ai * 128 + wr * 64 + m * 16, r = rloc + fr, rA = rloc + (fr & 7), rB = rA + 8;
            const size_t offA = (size_t)unit_row(u, rA) * D + colx, offB = (size_t)unit_row(u, rB) * D + colx;
            const bool okA = unit_valid(u, rA), okB = unit_valid(u, rB);
            const u32x4 hr = xchg8(sel4(lo, hb[sl][1], hb[sl][0]));
            const u32x4 hme[2] = {sel4(lo, hb[sl][0], hr), sel4(lo, hr, hb[sl][1])};
            u32x4 ume[2];
            if (UP) { const u32x4 ur = xchg8(sel4(lo, ub[sl][1], ub[sl][0])); ume[0] = sel4(lo, ub[sl][0], ur); ume[1] = sel4(lo, ur, ub[sl][1]); }
            if (it + NB < 8) {
                const int rN = ((it + NB) >> 2) * 128 + wr * 64 + ((it + NB) & 3) * 16 + (fr & 7);
                const size_t onA = (size_t)unit_row(u, rN) * D + colx, onB = (size_t)unit_row(u, rN + 8) * D + colx;
                hb[sl][0] = *(const u32x4*)(hin + onA); hb[sl][1] = *(const u32x4*)(hin + onB);
                if (UP) { ub[sl][0] = *(const u32x4*)(uple + onA); ub[sl][1] = *(const u32x4*)(uple + onB); }
            }
            const float rs = UP ? ssq_in[u.idx * 256 + r] : 1.0f;
            float s2 = 0.f; u32x4 Po[2];
#pragma unroll
            for (int bj = 0; bj < 2; ++bj) {
                float a[8];
#pragma unroll
                for (int n = 0; n < 2; ++n)
#pragma unroll
                    for (int e = 0; e < 4; ++e) a[4 * n + e] = acc[ai][bj][m][n][e];
                if (UP) {
                    const unsigned ua[4] = {ume[bj].x, ume[bj].y, ume[bj].z, ume[bj].w};
#pragma unroll
                    for (int j = 0; j < 4; ++j) { const f32x2 sg = sigmoid2((f32x2){a[2 * j], a[2 * j + 1]} * rs); a[2 * j] = bflo(ua[j]) * sg.x; a[2 * j + 1] = bfhi(ua[j]) * sg.y; }
                }
                const unsigned ha[4] = {hme[bj].x, hme[bj].y, hme[bj].z, hme[bj].w}; unsigned o[4];
#pragma unroll
                for (int j = 0; j < 4; ++j) { o[j] = cvt_pk_bf16(bflo(ha[j]) + a[2 * j], bfhi(ha[j]) + a[2 * j + 1]); const float o0 = bflo(o[j]), o1 = bfhi(o[j]); s2 += o0 * o0 + o1 * o1; }
                Po[bj] = (u32x4){o[0], o[1], o[2], o[3]};
            }
            const u32x4 orv = xchg8(sel4(lo, Po[1], Po[0]));
            if (okA) *(u32x4*)(hout + offA) = sel4(lo, Po[0], orv);
            if (okB) *(u32x4*)(hout + offB) = sel4(lo, orv, Po[1]);
            if (ssq_out) { s2 += __shfl_xor(s2, 16); s2 += __shfl_xor(s2, 32); if (fq == 0 && unit_valid(u, r)) ssq_out[(size_t)(u.pn * 4 + wc) * T + unit_row(u, r)] = s2; }
        }
    }
};

template <class Epi, class Sched>
DEVI void gemm_simple(int wv, const GemmShape g, const Sched& S, const Epi& E) {
    const int tid = opaque_tid(), wid = tid >> 6, lane = tid & 63, wr = wid >> 2, wc = wid & 3, fr = lane & 15, fq = lane >> 4;
    Unit u;
    for (int i = 0; S.next(i, u); ++i) {
        f32x4 acc[2][2][4][2];
#pragma unroll
        for (int a = 0; a < 2; ++a)
#pragma unroll
            for (int b = 0; b < 2; ++b)
#pragma unroll
                for (int m = 0; m < 4; ++m)
#pragma unroll
                    for (int n = 0; n < 2; ++n) acc[a][b][m][n] = (f32x4){0.f, 0.f, 0.f, 0.f};
        const bf16_t* ap[2][4];
#pragma unroll
        for (int ai = 0; ai < 2; ++ai)
#pragma unroll
            for (int m = 0; m < 4; ++m) {
                const int r = ai * 128 + wr * 64 + m * 16 + fr;
                const size_t grow = g.gatherA ? (size_t)u.rows[r] : (size_t)r;
                ap[ai][m] = u.A + grow * g.lda + 8 * fq;
            }
        size_t boff[2][2];
#pragma unroll
        for (int bj = 0; bj < 2; ++bj)
#pragma unroll
            for (int n = 0; n < 2; ++n) {
                const int c = Epi::CMAP ? (64 * wc + 32 * bj + perm32(16 * n + fr)) : (bj * 128 + wc * 32 + (Epi::PERM ? perm32(16 * n + fr) : 16 * n + fr));
                boff[bj][n] = (size_t)c * g.ldb + 8 * fq;
            }
        for (int k0 = 0; k0 < g.K; k0 += 32) {
            const bf16_t* bb = k0 < g.ksplit ? u.B0 + k0 : u.B1 + (k0 - g.ksplit);
            bf16x8 Af[2][4], Bf[2][2];
#pragma unroll
            for (int ai = 0; ai < 2; ++ai)
#pragma unroll
                for (int m = 0; m < 4; ++m) Af[ai][m] = *(const bf16x8*)(ap[ai][m] + k0);
#pragma unroll
            for (int bj = 0; bj < 2; ++bj)
#pragma unroll
                for (int n = 0; n < 2; ++n) Bf[bj][n] = *(const bf16x8*)(bb + boff[bj][n]);
#pragma unroll
            for (int ai = 0; ai < 2; ++ai)
#pragma unroll
                for (int bj = 0; bj < 2; ++bj)
#pragma unroll
                    for (int m = 0; m < 4; ++m)
#pragma unroll
                        for (int n = 0; n < 2; ++n) acc[ai][bj][m][n] = __builtin_amdgcn_mfma_f32_16x16x32_bf16(Bf[bj][n], Af[ai][m], acc[ai][bj][m][n], 0, 0, 0);
        }
        E(acc, u, wr, wc, fr, fq);
    }
}

constexpr int HTB = 128 * 64 * 2;
DEVI int lds_byte(int r, int c) { const int st = (r >> 4) * 2 + (c >> 5), rr = r & 15, cc = c & 31, ob = rr * 64 + cc * 2; return st * 1024 + (ob ^ (((ob >> 9) & 1) << 5)); }
DEVI void stage_rc(int b, int& R, int& C) { const int st = b / 1024, sb = b % 1024, swz = sb ^ (((sb >> 9) & 1) << 5); R = (st >> 1) * 16 + swz / 64; C = (st & 1) * 32 + (swz % 64) / 2; }
template <bool GATHER, class Epi, class Sched, class Hook, class PreA>
DEVI void gemm_fast(int wv, LAS unsigned char* lds, const GemmShape g, const Sched& S, const Epi& E, const Hook& hook, const PreA& prea) {
    const int tid = opaque_tid(), wid = __builtin_amdgcn_readfirstlane(tid >> 6), lane = tid & 63, wr = wid >> 2, wc = wid & 3, fr = lane & 15, fq = lane >> 4;
    const int nt = g.K / 64;
    int sR[2], sC[2]; unsigned voffB[2];
#pragma unroll
    for (int i = 0; i < 2; ++i) { stage_rc(tid * 16 + i * 8192, sR[i], sC[i]); const int Rb = Epi::CMAP ? (64 * (sR[i] >> 5) + perm32(sR[i] & 31)) : (Epi::PERM ? ((sR[i] & ~31) + perm32(sR[i] & 31)) : sR[i]); voffB[i] = (unsigned)(Rb * g.ldb + sC[i]) * 2u; }
    const size_t hstepB = (size_t)(Epi::CMAP ? 32 : 128) * g.ldb * 2;
    const unsigned ldsw = (unsigned)wid * 1024u;
    const int aoff = lds_byte(wr * 64 + fr, fq * 8), boff = lds_byte(wc * 32 + fr, fq * 8);
#define GF_SA(b, h) (((b) * 2 + (h)) * HTB)
#define GF_SB(b, h) ((4 + (b) * 2 + (h)) * HTB)
#define GF_STG(bufoff, base, v0, v1) do { \
        __builtin_amdgcn_global_load_lds((const unsigned*)((base) + (v0)), (LAS unsigned*)(lds + (bufoff) + ldsw), 16, 0, 0); \
        __builtin_amdgcn_global_load_lds((const unsigned*)((base) + (v1)), (LAS unsigned*)(lds + (bufoff) + ldsw + 8192), 16, 0, 0); } while (0)
#define GF_LDA(dst, b, h) do { _Pragma("unroll") for (int m = 0; m < 4; ++m) _Pragma("unroll") for (int k = 0; k < 2; ++k) dst[m][k] = *(const LAS bf16x8*)(lds + GF_SA(b, h) + aoff + m * 2048 + k * 1024); } while (0)
#define GF_LDB(dst, b, h) do { _Pragma("unroll") for (int n = 0; n < 2; ++n) _Pragma("unroll") for (int k = 0; k < 2; ++k) dst[n][k] = *(const LAS bf16x8*)(lds + GF_SB(b, h) + boff + n * 2048 + k * 1024); } while (0)
#define GF_MMA(ai, bj, At, Bt) do { __builtin_amdgcn_s_setprio(1); _Pragma("unroll") for (int m = 0; m < 4; ++m) _Pragma("unroll") for (int n = 0; n < 2; ++n) _Pragma("unroll") for (int k = 0; k < 2; ++k) \
        acc[ai][bj][m][n] = __builtin_amdgcn_mfma_f32_16x16x32_bf16(Bt[n][k], At[m][k], acc[ai][bj][m][n], 0, 0, 0); __builtin_amdgcn_s_setprio(0); } while (0)
#define GF_WAIT_V(n) asm volatile("s_waitcnt vmcnt(" #n ")" ::: "memory")
#define GF_WAIT_L(n) asm volatile("s_waitcnt lgkmcnt(" #n ")" ::: "memory")
#define GF_BAR __builtin_amdgcn_s_barrier()
#define GF_SCHED __builtin_amdgcn_sched_barrier(0)
#define GF_APTR(u, kt) ((const char*)(u).A + (size_t)(kt) * 128)
#define GF_BPTR(u, kt) ((const char*)(((kt) * 64 < g.ksplit) ? (u).B0 + (kt) * 64 : (u).B1 + ((kt) * 64 - g.ksplit)))
#define GF_OFFA(dst, u) do { _Pragma("unroll") for (int h = 0; h < 2; ++h) _Pragma("unroll") for (int i = 0; i < 2; ++i) { const int row_ = h * 128 + sR[i]; \
        const unsigned grow_ = GATHER ? (unsigned)(u).rows[row_] : (unsigned)row_; dst[h][i] = (grow_ * (unsigned)g.lda + (unsigned)sC[i]) * 2u; } } while (0)
    __syncthreads();
    Unit cur, nxt; int ui = 0;
    if (!S.next(0, cur)) return;
    unsigned offA[2][2];
    if (!GATHER) GF_OFFA(offA, cur);
    f32x4 acc[2][2][4][2];
#pragma unroll
    for (int a = 0; a < 2; ++a)
#pragma unroll
        for (int b = 0; b < 2; ++b)
#pragma unroll
            for (int m = 0; m < 4; ++m)
#pragma unroll
                for (int n = 0; n < 2; ++n) acc[a][b][m][n] = (f32x4){0.f, 0.f, 0.f, 0.f};
    bf16x8 At[4][2], B0[2][2], B1[2][2];
    {
        const char* a0 = GF_APTR(cur, 0); const char* b0 = GF_BPTR(cur, 0); const char* a1 = GF_APTR(cur, 1); const char* b1 = GF_BPTR(cur, 1);
        GF_WAIT_L(0);
        GF_STG(GF_SB(0, 0), b0, voffB[0], voffB[1]); GF_STG(GF_SB(0, 1), b0 + hstepB, voffB[0], voffB[1]);
        if (GATHER) { prea(); GF_OFFA(offA, cur); GF_WAIT_L(0); }
        GF_STG(GF_SA(0, 0), a0, offA[0][0], offA[0][1]); GF_STG(GF_SA(0, 1), a0, offA[1][0], offA[1][1]);
        hook();
        if (wr == 1) GF_BAR;
        GF_WAIT_V(2); GF_BAR;
        GF_STG(GF_SB(1, 0), b1, voffB[0], voffB[1]); GF_STG(GF_SA(1, 0), a1, offA[0][0], offA[0][1]); GF_STG(GF_SB(1, 1), b1 + hstepB, voffB[0], voffB[1]);
        GF_WAIT_V(6); GF_BAR;
    }
    for (;;) {
        const bool has_next = S.next(ui + 1, nxt);
#pragma unroll 1
        for (int t = 0; t < nt; t += 2) {
            const bool last = (t == nt - 2), useN = last && has_next;
            const int kt2 = last ? 0 : t + 2;
            const char* a1 = GF_APTR(cur, t + 1);
            const char* a2 = useN ? GF_APTR(nxt, kt2) : GF_APTR(cur, kt2); const char* a3 = a2 + 128;
            const char* b2 = useN ? GF_BPTR(nxt, kt2) : GF_BPTR(cur, kt2);
            const char* b3 = useN ? GF_BPTR(nxt, kt2 + 1) : GF_BPTR(cur, kt2 + 1);
            GF_LDB(B0, 0, 0); GF_LDB(B1, 0, 1); GF_SCHED; GF_LDA(At, 0, 0); GF_STG(GF_SA(1, 1), a1, offA[1][0], offA[1][1]);
            if (GATHER && useN) { GF_OFFA(offA, nxt); }
            GF_WAIT_V(8); GF_WAIT_L(0); GF_BAR; GF_MMA(0, 0, At, B0); GF_MMA(0, 1, At, B1); GF_BAR; GF_SCHED;
            GF_LDA(At, 0, 1); GF_STG(GF_SB(0, 0), b2, voffB[0], voffB[1]); GF_STG(GF_SB(0, 1), b2 + hstepB, voffB[0], voffB[1]); GF_STG(GF_SA(0, 0), a2, offA[0][0], offA[0][1]);
            GF_WAIT_V(8); GF_WAIT_L(0); GF_BAR; GF_MMA(1, 0, At, B0); GF_MMA(1, 1, At, B1); GF_BAR; GF_SCHED;
            GF_LDB(B0, 1, 0); GF_LDB(B1, 1, 1); GF_SCHED; GF_LDA(At, 1, 0); GF_STG(GF_SA(0, 1), a2, offA[1][0], offA[1][1]);
            GF_WAIT_V(8); GF_WAIT_L(0); GF_BAR; GF_MMA(0, 0, At, B0); GF_MMA(0, 1, At, B1); GF_BAR; GF_SCHED;
            GF_LDA(At, 1, 1); GF_STG(GF_SB(1, 0), b3, voffB[0], voffB[1]); GF_STG(GF_SB(1, 1), b3 + hstepB, voffB[0], voffB[1]); GF_STG(GF_SA(1, 0), a3, offA[0][0], offA[0][1]);
            GF_WAIT_V(8); GF_WAIT_L(0); GF_BAR; GF_MMA(1, 0, At, B0); GF_MMA(1, 1, At, B1); GF_BAR; GF_SCHED;
        }
        if (wr == 0) GF_BAR;
        E(acc, cur, wr, wc, fr, fq);
        if (!has_next) break;
#pragma unroll
        for (int a = 0; a < 2; ++a)
#pragma unroll
            for (int b = 0; b < 2; ++b)
#pragma unroll
                for (int m = 0; m < 4; ++m)
#pragma unroll
                    for (int n = 0; n < 2; ++n) acc[a][b][m][n] = (f32x4){0.f, 0.f, 0.f, 0.f};
        cur = nxt; ++ui;
        if (wr == 1) GF_BAR;
    }
    GF_WAIT_V(0);
    GF_BAR;
#undef GF_SA
#undef GF_SB
#undef GF_STG
#undef GF_LDA
#undef GF_LDB
#undef GF_MMA
#undef GF_WAIT_V
#undef GF_WAIT_L
#undef GF_BAR
#undef GF_SCHED
#undef GF_APTR
#undef GF_BPTR
#undef GF_OFFA
}
template <bool GATHER, class Epi, class Sched, class Hook, class PreA>
DEVI void gemm_run(int wv, unsigned char* lds, const GemmShape g, const Sched& S, const Epi& E, const Hook& hook, const PreA& prea) {
#if USE_FAST
    gemm_fast<GATHER>(wv, (LAS unsigned char*)lds + LDS_STAGE, g, S, E, hook, prea);
#else
    prea(); hook(); __syncthreads(); gemm_simple(wv, g, S, E);
#endif
}
template <bool GATHER, class Epi, class Sched, class Hook>
DEVI void gemm_run(int wv, unsigned char* lds, const GemmShape g, const Sched& S, const Epi& E, const Hook& hook) { gemm_run<GATHER>(wv, lds, g, S, E, hook, NoHook{}); }
template <bool GATHER, class Epi, class Sched>
DEVI void gemm_run(int wv, unsigned char* lds, const GemmShape g, const Sched& S, const Epi& E) { gemm_run<GATHER>(wv, lds, g, S, E, NoHook{}); }

DEVI void phase_aproj(const Params& P, int wv, int vc, unsigned char* lds_, int jl, int layer) {
    const int tid = opaque_tid(), lane = tid & 63, wave = tid >> 6, l15 = lane & 15, lq = lane >> 4;
    LAS unsigned char* Wl = (LAS unsigned char*)lds_;
    LAS float* red = (LAS float*)((LAS unsigned char*)lds_ + 33024);
    const bf16_t* hb0 = (const bf16_t*)(P.ws + WS_HB0);
    const bf16_t* wa = (const bf16_t*)(P.ws + WS_GLA_IN) + ((size_t)jl * GLA_IN + GLA_Z) * D;
    const float* ssq = (const float*)(P.ws + WS_SSQP) + (size_t)(layer * 2 + 0) * T * 16;
    float* a = (float*)(P.ws + WS_AGATE);
    const int astep = (int)(gridDim.x >> 3), mt = wave & 3, kh = wave >> 2;
    bf16x8 av[16]; float rsv = 0.f;
    if ((vc >> 3) < 32) {
        const int row = ((vc & 7) * 32 + (vc >> 3)) * 64 + 16 * mt + l15;
        const bf16_t* ap = hb0 + (size_t)row * D + kh * 512 + 8 * lq;
#pragma unroll
        for (int ks = 0; ks < 16; ++ks) av[ks] = *(const bf16x8*)(ap + 32 * ks);
        rsv = rstd16s(ssq, row);
    }
    __syncthreads();
    {
        u32x4 wv4[4];
#pragma unroll
        for (int i = 0; i < 4; ++i) wv4[i] = ((const u32x4*)wa)[tid + NTHREADS * i];
#pragma unroll
        for (int i = 0; i < 4; ++i) { const int q = tid + NTHREADS * i; *(LAS u32x4*)(Wl + (q >> 7) * 2064 + (q & 127) * 16) = wv4[i]; }
    }
    __syncthreads();
    for (int bi_ = vc >> 3; bi_ < 32; bi_ += astep) {
        const int blk = (vc & 7) * 32 + bi_;
        const int row = blk * 64 + 16 * mt + l15;
        f32x4 acc = (f32x4){0.f, 0.f, 0.f, 0.f};
        const LAS unsigned char* bp = Wl + l15 * 2064 + (kh * 512 + 8 * lq) * 2;
        bf16x8 ac[16]; const float rsc = rsv;
#pragma unroll
        for (int ks = 0; ks < 16; ++ks) ac[ks] = av[ks];
        if (bi_ + astep < 32) {
            const int rown = row + astep * 64;
            const bf16_t* ap = hb0 + (size_t)rown * D + kh * 512 + 8 * lq;
#pragma unroll
            for (int ks = 0; ks < 16; ++ks) av[ks] = *(const bf16x8*)(ap + 32 * ks);
            rsv = rstd16s(ssq, rown);
        }
#pragma unroll
        for (int ks = 0; ks < 16; ++ks) acc = __builtin_amdgcn_mfma_f32_16x16x32_bf16(*(const LAS bf16x8*)(bp + 64 * ks), ac[ks], acc, 0, 0, 0);
        __syncthreads();
        if (kh == 1) *(LAS f32x4*)(red + (mt * 64 + lane) * 4) = acc;
        __syncthreads();
        if (kh == 0) {
            const f32x4 o = (acc + *(const LAS f32x4*)(red + (mt * 64 + lane) * 4)) * rsc;
            *(f32x4*)(a + (size_t)row * 16 + 4 * lq) = o;
        }
    }
}
DEVI void phase_g2_simple(const Params& P, int wv, int vc, unsigned char* lds, int jl) {
    const int tid = opaque_tid();
    float* bc = (float*)lds;
    float* ke = (float*)(lds + 32768);
    float* qs = (float*)(lds + 65536);
    float* al = (float*)(lds + 67584);
    float* vl = (float*)(lds + 71680);
    bf16_t* zq = (bf16_t*)(P.ws + WS_ZBUF);
    bf16_t* ST = (bf16_t*)(P.ws + WS_BUF2);
    float* bend = (float*)(P.ws + WS_BEND);
    const float* ag = (const float*)(P.ws + WS_AGATE);
    const float* wgu = P.in[I_GLA_WGU] + (size_t)jl * 16 * 512;
    const float* bg = P.in[I_GLA_BG] + jl * 512;
    for (int ui_ = vc >> 3; ui_ < 128; ui_ += (int)(gridDim.x >> 3)) {
        const int u = (vc & 7) * 128 + ui_;
        const int h = u & 3, n = (u >> 2) & 31, b = u >> 7;
        const int t0 = b * SEQ + n * GCH;
        for (int e = tid; e < 64 * 16; e += NTHREADS) al[e] = ag[(size_t)t0 * 16 + e];
        __syncthreads();
        {
            const int kk = tid & 127, tq = tid >> 7, hk = h * HK + kk;
            float wcol[16];
#pragma unroll
            for (int j = 0; j < 16; ++j) wcol[j] = wgu[j * 512 + hk];
            const float bias = bg[hk];
            float run = 0.f;
            for (int tt = 0; tt < 16; ++tt) {
                const int t = tq * 16 + tt; float x = bias;
#pragma unroll
                for (int j = 0; j < 16; ++j) x += al[t * 16 + j] * wcol[j];
                run += logsigmoidf_(x) * (1.0f / 16.0f);
                bc[t * 128 + kk] = run;
            }
            qs[tq * 128 + kk] = run;
            __syncthreads();
            float pre = 0.f;
            for (int q = 0; q < tq; ++q) pre += qs[q * 128 + kk];
            for (int tt = 0; tt < 16; ++tt) bc[(tq * 16 + tt) * 128 + kk] += pre;
        }
        __syncthreads();
        for (int e = tid; e < 64 * 128; e += NTHREADS) {
            const int t = e >> 7, kk = e & 127;
            const float bcv = bc[t * 128 + kk], be = bc[63 * 128 + kk];
            const size_t qoff = (size_t)(t0 + t) * GLA_Z + h * HK + kk;
            const float qv = bf2f(zq[qoff]), kv = bf2f(zq[qoff + 512]);
            zq[qoff] = (bf16_t)f2bf(qv * 0.08838834764831845f * __expf(bcv));
            zq[qoff + 512] = (bf16_t)f2bf(kv * __expf(-bcv));
            ke[t * 128 + kk] = bf2f(f2bf(kv * __expf(be - bcv)));
        }
        for (int e = tid; e < 64 * 256; e += NTHREADS) { const int t = e >> 8, vv = e & 255; vl[e] = bf2f(zq[(size_t)(t0 + t) * GLA_Z + 1024 + h * HV + vv]); }
        if (tid < 128) bend[u * 128 + tid] = bc[63 * 128 + tid];
        __syncthreads();
        {
            const int kk = tid & 127, vg = tid >> 7;
            float kcol[64];
#pragma unroll
            for (int t = 0; t < 64; ++t) kcol[t] = ke[t * 128 + kk];
            for (int vi = 0; vi < 64; ++vi) {
                const int vv = vg * 64 + vi; float s = 0.f;
#pragma unroll
                for (int t = 0; t < 64; ++t) s += kcol[t] * vl[t * 256 + vv];
                ST[(size_t)u * 32768 + vv * 128 + kk] = (bf16_t)f2bf(s);
            }
        }
        __syncthreads();
    }
}
DEVI void phase_g3(const Params& P, int wv, int vc, unsigned char* lds_) {
    const int tid = opaque_tid();
    LAS float* dec = (LAS float*)((LAS unsigned char*)lds_);
    unsigned char* ST = P.ws + WS_BUF2;
    const float* bend = (const float*)(P.ws + WS_BEND);
    for (int wi_ = vc >> 3; wi_ < 32; wi_ += (int)(gridDim.x >> 3)) {
        const int wg = (vc & 7) * 32 + wi_;
        const int vg = wg & 7, h = (wg >> 3) & 3, b = wg >> 5;
        int tl = tid; asm volatile("" : "+v"(tl));
        const int kc = tl & 15, vv = vg * 32 + (tl >> 4);
        __syncthreads();
        u32x2 kv[32];
        unsigned char* base = ST + (size_t)(b * 128 + h) * 32768 + vv * 128 + kc * 8;
#pragma unroll
        for (int n = 0; n < 32; ++n) kv[n] = *(const u32x2*)(base + (size_t)n * 4 * 32768);
#pragma unroll
        for (int i = 0; i < 8; ++i) { const int e = tl + NTHREADS * i; const int n = e >> 7, kk = e & 127; dec[e] = __expf(bend[((b * 32 + n) * 4 + h) * 128 + kk]); }
        __syncthreads();
        float st[8]; float zero = 0.f; asm volatile("" : "+v"(zero));
#pragma unroll
        for (int j = 0; j < 8; ++j) st[j] = zero;
#pragma unroll
        for (int n = 0; n < 32; ++n) {
            u32x2 o; o.x = pk4_fp8(st[0], st[1], st[2], st[3]); o.y = pk4_fp8(st[4], st[5], st[6], st[7]);
            *(u32x2*)(base + (size_t)n * 4 * 32768) = o;
            const f32x4 d0 = *(const LAS f32x4*)(dec + n * 128 + kc * 8), d1 = *(const LAS f32x4*)(dec + n * 128 + kc * 8 + 4);
            const f32x2 k01 = fp8lo2(kv[n].x), k23 = fp8hi2(kv[n].x), k45 = fp8lo2(kv[n].y), k67 = fp8hi2(kv[n].y);
            st[0] = d0.x * st[0] + k01.x; st[1] = d0.y * st[1] + k01.y;
            st[2] = d0.z * st[2] + k23.x; st[3] = d0.w * st[3] + k23.y;
            st[4] = d1.x * st[4] + k45.x; st[5] = d1.y * st[5] + k45.y;
            st[6] = d1.z * st[6] + k67.x; st[7] = d1.w * st[7] + k67.y;
        }
    }
}
DEVI void phase_g4_simple(const Params& P, int wv, int vc, unsigned char* lds, int jl) {
    const int tid = opaque_tid(), lane = tid & 63, wave = tid >> 6;
    float* qd = (float*)lds;
    float* kd = (float*)(lds + 33024);
    float* Pm = (float*)(lds + 66048);
    float* O = (float*)(lds + 82688);
    const bf16_t* zq = (const bf16_t*)(P.ws + WS_ZBUF);
    bf16_t* ob = (bf16_t*)(P.ws + WS_ZBUF + ZB_OB);
    const bf16_t* ST = (const bf16_t*)(P.ws + WS_BUF2);
    const float* gh = P.in[I_GLA_GH] + jl * 1024;
    for (int ui_ = vc >> 3; ui_ < 128; ui_ += (int)(gridDim.x >> 3)) {
        const int u = (vc & 7) * 128 + ui_;
        const int h = u & 3, n = (u >> 2) & 31, b = u >> 7;
        const int t0 = b * SEQ + n * GCH;
        for (int e = tid; e < 64 * 128; e += NTHREADS) {
            const int t = e >> 7, kk = e & 127; const size_t qoff = (size_t)(t0 + t) * GLA_Z + h * HK + kk;
            qd[t * 129 + kk] = bf2f(zq[qoff]); kd[t * 129 + kk] = bf2f(zq[qoff + 512]);
        }
        __syncthreads();
        for (int e = tid; e < 64 * 64; e += NTHREADS) {
            const int i = e >> 6, j = e & 63; float s = 0.f;
            if (j <= i) { for (int kk = 0; kk < 128; ++kk) s += qd[i * 129 + kk] * kd[j * 129 + kk]; }
            Pm[i * 65 + j] = s;
        }
        __syncthreads();
        {
            const int vv = tid & 255, ih = tid >> 8;
#pragma unroll 1
            for (int hf = 0; hf < 2; ++hf) {
                float S[64];
                const u32x4* sp = (const u32x4*)(ST + (size_t)u * 32768 + vv * 128 + hf * 64);
#pragma unroll
                for (int c = 0; c < 8; ++c) { const u32x4 w = sp[c]; S[8 * c + 0] = bflo(w.x); S[8 * c + 1] = bfhi(w.x); S[8 * c + 2] = bflo(w.y); S[8 * c + 3] = bfhi(w.y); S[8 * c + 4] = bflo(w.z); S[8 * c + 5] = bfhi(w.z); S[8 * c + 6] = bflo(w.w); S[8 * c + 7] = bfhi(w.w); }
#pragma unroll 1
                for (int ii = 0; ii < 32; ++ii) {
                    const int i = ih * 32 + ii; float o = hf ? O[i * 256 + vv] : 0.f;
#pragma unroll
                    for (int kk = 0; kk < 64; ++kk) o += qd[i * 129 + hf * 64 + kk] * S[kk];
                    O[i * 256 + vv] = o;
                }
            }
            {
                float V[64];
#pragma unroll
                for (int j = 0; j < 64; ++j) V[j] = bf2f(zq[(size_t)(t0 + j) * GLA_Z + 1024 + h * HV + vv]);
                for (int ii = 0; ii < 32; ++ii) {
                    const int i = ih * 32 + ii; float o = O[i * 256 + vv];
#pragma unroll
                    for (int j = 0; j < 64; ++j) o += Pm[i * 65 + j] * V[j];
                    O[i * 256 + vv] = o;
                }
            }
        }
        __syncthreads();
        for (int ii = 0; ii < 8; ++ii) {
            const int i = wave * 8 + ii;
            float x[4]; float s = 0.f;
#pragma unroll
            for (int q = 0; q < 4; ++q) { x[q] = O[i * 256 + lane + 64 * q]; s += x[q] * x[q]; }
            s = wave_sum(s);
            const float rs = rsqrtf(s * (1.0f / HV) + EPS);
#pragma unroll
            for (int q = 0; q < 4; ++q) {
                const int vv = lane + 64 * q;
                const float r = bf2f(zq[(size_t)(t0 + i) * GLA_Z + 2048 + h * HV + vv]);
                ob[(size_t)(t0 + i) * 1024 + h * HV + vv] = (bf16_t)f2bf(x[q] * rs * gh[h * HV + vv] * siluf_(r));
            }
        }
        __syncthreads();
    }
}

DEVI void phase_s2_simple(const Params& P, int wv, int vc, unsigned char* lds, int jl) {
    const int tid = opaque_tid();
    float* w = (float*)lds;
    float* mu = (float*)(lds + 65536);
    float* rsd = (float*)(lds + 65536 + 512);
    const bf16_t* z = (const bf16_t*)(P.ws + WS_ZBUF);
    bf16_t* ug = (bf16_t*)(P.ws + WS_BUF2);
    const float* lnstat = (const float*)(P.ws + WS_LNP) + (size_t)jl * T * 64;
    const bf16_t* wsb = (const bf16_t*)(P.ws + WS_SGUWS) + (size_t)jl * 8 * 128 * 128;
    const float* lng = P.in[I_SGU_LNG] + jl * SGU_W; const float* lnb = P.in[I_SGU_LNB] + jl * SGU_W;
    const float* bs = P.in[I_SGU_BS] + jl * 8 * 128;
    for (int ui_ = vc >> 3; ui_ < 128; ui_ += (int)(gridDim.x >> 3)) {
        const int u = (vc & 7) * 128 + ui_;
        const int g = u & 7, n = (u >> 3) & 15, b = u >> 7;
        const int t0 = b * SEQ + n * SCH;
        for (int e = tid; e < 128 * 128; e += NTHREADS) w[e] = bf2f(wsb[(size_t)g * 16384 + e]);
        if (tid < 128) {
            float s1 = 0.f, s2 = 0.f; f32x4 sv[16];
#pragma unroll
            for (int q = 0; q < 16; ++q) sv[q] = *(const f32x4*)(lnstat + (size_t)(t0 + tid) * 64 + 4 * q);
#pragma unroll
            for (int q = 0; q < 16; ++q) { s1 += sv[q].x; s2 += sv[q].y; s1 += sv[q].z; s2 += sv[q].w; }
            const float mean = s1 * (1.0f / SGU_W); const float var = fmaxf(s2 * (1.0f / SGU_W) - mean * mean, 0.f);
            mu[tid] = mean; rsd[tid] = rsqrtf(var + EPS);
        }
        __syncthreads();
        {
            const int c = tid & 255, th = tid >> 8, col = g * SGC + c;
            const float gg = lng[col], bb = lnb[col];
            float vn[128];
#pragma unroll
            for (int s = 0; s < 128; ++s) { const float x = bf2f(z[(size_t)(t0 + s) * SGU_Z + SGU_W + col]); vn[s] = (x - mu[s]) * rsd[s] * gg + bb; }
            for (int tt = 0; tt < 64; ++tt) {
                const int t = 2 * tt + th; float s = bs[g * 128 + t];
#pragma unroll
                for (int sp = 0; sp < 128; ++sp) s += w[t * 128 + sp] * vn[sp];
                const float uv = bf2f(z[(size_t)(t0 + t) * SGU_Z + col]);
                ug[(size_t)(t0 + t) * SGU_W + col] = (bf16_t)f2bf(uv * s);
            }
        }
        __syncthreads();
    }
}


typedef short v4i16_t __attribute__((ext_vector_type(4)));
DEVI bf16x8 lds_col8(const LAS unsigned short* p, int ld, int l15) {
    const LAS unsigned short* a = p + ((l15 >> 2) * ld + 4 * (l15 & 3) - l15);
    const v4i16_t lo = __builtin_amdgcn_ds_read_tr16_b64_v4i16((LAS v4i16_t*)a), hi = __builtin_amdgcn_ds_read_tr16_b64_v4i16((LAS v4i16_t*)(a + 4 * ld));
    bf16x8 r; r[0] = lo[0]; r[1] = lo[1]; r[2] = lo[2]; r[3] = lo[3]; r[4] = hi[0]; r[5] = hi[1]; r[6] = hi[2]; r[7] = hi[3];
    return r;
}
DEVI f32x4 mfma16(bf16x8 a, bf16x8 b, f32x4 c) { return __builtin_amdgcn_mfma_f32_16x16x32_bf16(a, b, c, 0, 0, 0); }

struct G2Pre { float al[2]; u32x4 vw[4], qw[2], kw[2]; };
DEVI void g2_load(G2Pre& p, const bf16_t* zq, const float* ag, int u, int tid) {
    const int h = u & 3, n = (u >> 2) & 31, b = u >> 7, t0 = b * SEQ + n * GCH;
#pragma unroll
    for (int i = 0; i < 2; ++i) p.al[i] = ag[(size_t)t0 * 16 + tid + NTHREADS * i];
#pragma unroll
    for (int i = 0; i < 4; ++i) {
        const int c = tid + NTHREADS * i, row = c >> 5, cc = c & 31;
        p.vw[i] = *(const u32x4*)(zq + (size_t)(t0 + row) * GLA_Z + 1024 + h * HV + 8 * cc);
    }
#pragma unroll
    for (int i = 0; i < 2; ++i) {
        const int c = tid + NTHREADS * i, t = c >> 4, cc = c & 15;
        const size_t qoff = (size_t)(t0 + t) * GLA_Z + h * HK + 8 * cc;
        p.qw[i] = *(const u32x4*)(zq + qoff); p.kw[i] = *(const u32x4*)(zq + qoff + 512);
    }
}
template <bool HAS_NEXT>
DEVI void g2_unit(G2Pre& nx, bf16_t* zq, unsigned char* ST, float* bend, const float* ag, const float (&wcol)[16], float bias, LAS unsigned char* lds, int u, int u_next,
                  int tid, int wave, int l15, int lq) {
    LAS float* bc = (LAS float*)lds;
    LAS float* al = (LAS float*)(lds + 33024);
    LAS float* qs = (LAS float*)(lds + 37120);
    LAS unsigned short* Ke = (LAS unsigned short*)(lds + 39168);
    LAS unsigned short* V = (LAS unsigned short*)(lds + 56064);
    const int h = u & 3, n = (u >> 2) & 31, b = u >> 7;
    const int t0 = b * SEQ + n * GCH;
    __syncthreads();
#pragma unroll
    for (int i = 0; i < 2; ++i) al[tid + NTHREADS * i] = nx.al[i];
#pragma unroll
    for (int i = 0; i < 4; ++i) {
        const int c = tid + NTHREADS * i, row = c >> 5, cc = c & 31;
        const u32x4 w = nx.vw[i];
        *(LAS u32x2*)(V + row * 260 + cc * 8) = (u32x2){w.x, w.y}; *(LAS u32x2*)(V + row * 260 + cc * 8 + 4) = (u32x2){w.z, w.w};
    }
    const u32x4 qwc[2] = {nx.qw[0], nx.qw[1]}, kwc[2] = {nx.kw[0], nx.kw[1]};
    if (HAS_NEXT) g2_load(nx, zq, ag, u_next, tid);
    __syncthreads();
    {
        const int kk = tid & 127, tq = tid >> 7;
        float run = 0.f;
        for (int tt = 0; tt < 16; ++tt) {
            const int t = tq * 16 + tt; float x = bias;
#pragma unroll
            for (int j = 0; j < 16; ++j) x += al[t * 16 + j] * wcol[j];
            run += logsigmoidf_(x) * (1.0f / 16.0f);
            bc[t * 129 + kk] = run;
        }
        qs[tq * 128 + kk] = run;
        __syncthreads();
        float pre = 0.f;
        for (int q = 0; q < tq; ++q) pre += qs[q * 128 + kk];
        for (int tt = 0; tt < 16; ++tt) bc[(tq * 16 + tt) * 129 + kk] += pre;
    }
    __syncthreads();
#pragma unroll
    for (int i = 0; i < 2; ++i) {
        const int c = tid + NTHREADS * i, t = c >> 4, cc = c & 15;
        const size_t qoff = (size_t)(t0 + t) * GLA_Z + h * HK + 8 * cc;
        const u32x4 qw = qwc[i], kw = kwc[i];
        const unsigned qa[4] = {qw.x, qw.y, qw.z, qw.w}, ka[4] = {kw.x, kw.y, kw.z, kw.w};
        unsigned qo[4], ko[4], eo[4];
#pragma unroll
        for (int j = 0; j < 4; ++j) {
            const float b0 = bc[t * 129 + 8 * cc + 2 * j], b1 = bc[t * 129 + 8 * cc + 2 * j + 1];
            const float e0 = bc[63 * 129 + 8 * cc + 2 * j], e1 = bc[63 * 129 + 8 * cc + 2 * j + 1];
            const float q0 = bflo(qa[j]), q1 = bfhi(qa[j]), k0 = bflo(ka[j]), k1 = bfhi(ka[j]);
            qo[j] = cvt_pk_bf16(q0 * 0.08838834764831845f * __expf(b0), q1 * 0.08838834764831845f * __expf(b1));
            ko[j] = cvt_pk_bf16(k0 * __expf(-b0), k1 * __expf(-b1));
            eo[j] = cvt_pk_bf16(k0 * __expf(e0 - b0), k1 * __expf(e1 - b1));
        }
        *(u32x4*)(zq + qoff) = (u32x4){qo[0], qo[1], qo[2], qo[3]};
        *(u32x4*)(zq + qoff + 512) = (u32x4){ko[0], ko[1], ko[2], ko[3]};
        *(LAS u32x2*)(Ke + t * 132 + cc * 8) = (u32x2){eo[0], eo[1]}; *(LAS u32x2*)(Ke + t * 132 + cc * 8 + 4) = (u32x2){eo[2], eo[3]};
    }
    if (tid < 128) bend[u * 128 + tid] = bc[63 * 129 + tid];
    __syncthreads();
    {
        bf16x8 Av[2][2];
#pragma unroll
        for (int vt = 0; vt < 2; ++vt)
#pragma unroll
            for (int ks = 0; ks < 2; ++ks) Av[vt][ks] = lds_col8(V + (32 * ks + 8 * lq) * 260 + 16 * (2 * wave + vt) + l15, 260, l15);
#pragma unroll 2
        for (int kt = 0; kt < 8; ++kt) {
            bf16x8 Bk[2];
#pragma unroll
            for (int ks = 0; ks < 2; ++ks) Bk[ks] = lds_col8(Ke + (32 * ks + 8 * lq) * 132 + 16 * kt + l15, 132, l15);
#pragma unroll
            for (int vt = 0; vt < 2; ++vt) {
                f32x4 acc = (f32x4){0.f, 0.f, 0.f, 0.f};
                acc = mfma16(Bk[0], Av[vt][0], acc); acc = mfma16(Bk[1], Av[vt][1], acc);
                *(unsigned*)(ST + (size_t)u * 32768 + (16 * (2 * wave + vt) + l15) * 128 + 16 * kt + 4 * lq) = pk4_fp8(acc.x, acc.y, acc.z, acc.w);
            }
        }
    }
}
DEVI void phase_g2_fast(const Params& P, int wv, int vc, unsigned char* lds_, int jl) {
    const int tid = opaque_tid(), lane = tid & 63, wave = tid >> 6, l15 = lane & 15, lq = lane >> 4;
    LAS unsigned char* lds = (LAS unsigned char*)lds_;
    bf16_t* zq = (bf16_t*)(P.ws + WS_ZBUF);
    unsigned char* ST = P.ws + WS_BUF2;
    float* bend = (float*)(P.ws + WS_BEND);
    const float* ag = (const float*)(P.ws + WS_AGATE);
    const float* wgu = P.in[I_GLA_WGU] + (size_t)jl * 16 * 512;
    const float* bg = P.in[I_GLA_BG] + jl * 512;
    const int step = (int)(gridDim.x >> 3), ubase = (vc & 7) * 128;
    int ui_ = vc >> 3;
    if (ui_ >= 128) return;
    G2Pre nx;
    g2_load(nx, zq, ag, ubase + ui_, tid);
    for (;;) {
        const int u = ubase + ui_, hk = (u & 3) * HK + (tid & 127);
        float wcol[16];
#pragma unroll
        for (int j = 0; j < 16; ++j) wcol[j] = wgu[j * 512 + hk];
        const float bias = bg[hk];
        if (ui_ + step < 128) { g2_unit<true>(nx, zq, ST, bend, ag, wcol, bias, lds, u, u + step, tid, wave, l15, lq); ui_ += step; }
        else { g2_unit<false>(nx, zq, ST, bend, ag, wcol, bias, lds, u, u, tid, wave, l15, lq); break; }
    }
}

struct G4Pre { u32x2 Bs8[2][4]; u32x2 rr[4][2]; u32x4 qw[2], kw[2], vw[4]; };
DEVI void g4_load(G4Pre& p, const bf16_t* zq, const unsigned char* ST, int u, int tid, int wave, int l15, int lq) {
    const int h = u & 3, n = (u >> 2) & 31, b = u >> 7, t0 = b * SEQ + n * GCH;
#pragma unroll
    for (int nt = 0; nt < 2; ++nt)
#pragma unroll
        for (int ks = 0; ks < 4; ++ks) p.Bs8[nt][ks] = *(const u32x2*)(ST + (size_t)u * 32768 + (16 * (2 * wave + nt) + l15) * 128 + 32 * ks + 8 * lq);
#pragma unroll
    for (int mt = 0; mt < 4; ++mt)
#pragma unroll
        for (int nt = 0; nt < 2; ++nt) p.rr[mt][nt] = *(const u32x2*)(zq + (size_t)(t0 + 16 * mt + l15) * GLA_Z + 2048 + h * HV + 16 * (2 * wave + nt) + 4 * lq);
#pragma unroll
    for (int i = 0; i < 2; ++i) {
        const int c = tid + NTHREADS * i, row = c >> 4, cc = c & 15;
        const size_t qoff = (size_t)(t0 + row) * GLA_Z + h * HK + 8 * cc;
        p.qw[i] = *(const u32x4*)(zq + qoff); p.kw[i] = *(const u32x4*)(zq + qoff + 512);
    }
#pragma unroll
    for (int i = 0; i < 4; ++i) {
        const int c = tid + NTHREADS * i, row = c >> 5, cc = c & 31;
        p.vw[i] = *(const u32x4*)(zq + (size_t)(t0 + row) * GLA_Z + 1024 + h * HV + 8 * cc);
    }
}
template <bool HAS_NEXT>
DEVI void g4_unit(G4Pre& nx, const bf16_t* zq, bf16_t* ob, const unsigned char* ST, const f32x4 (&g4)[2], LAS unsigned char* lds, int u, int u_next, int tid, int wave, int l15, int lq) {
    LAS unsigned char* Q = lds;
    LAS unsigned char* Kd = lds + 17408;
    LAS unsigned short* V = (LAS unsigned short*)(lds + 34816);
    LAS unsigned short* Pm = (LAS unsigned short*)(lds + 68096);
    LAS float* part = (LAS float*)(lds + 77312);
    const int h = u & 3, n = (u >> 2) & 31, b = u >> 7;
    const int t0 = b * SEQ + n * GCH;
    __syncthreads();
    bf16x8 Bs[2][4]; u32x2 rr[4][2];
#pragma unroll
    for (int mt = 0; mt < 4; ++mt)
#pragma unroll
        for (int nt = 0; nt < 2; ++nt) rr[mt][nt] = nx.rr[mt][nt];
#pragma unroll
    for (int i = 0; i < 2; ++i) {
        const int c = tid + NTHREADS * i, row = c >> 4, cc = c & 15;
        *(LAS u32x4*)(Q + row * 272 + cc * 16) = nx.qw[i]; *(LAS u32x4*)(Kd + row * 272 + cc * 16) = nx.kw[i];
    }
#pragma unroll
    for (int i = 0; i < 4; ++i) {
        const int c = tid + NTHREADS * i, row = c >> 5, cc = c & 31;
        const u32x4 w = nx.vw[i];
        *(LAS u32x2*)(V + row * 260 + cc * 8) = (u32x2){w.x, w.y}; *(LAS u32x2*)(V + row * 260 + cc * 8 + 4) = (u32x2){w.z, w.w};
    }
#pragma unroll
    for (int nt = 0; nt < 2; ++nt)
#pragma unroll
        for (int ks = 0; ks < 4; ++ks) {
            const f32x2 s01 = fp8lo2(nx.Bs8[nt][ks].x), s23 = fp8hi2(nx.Bs8[nt][ks].x), s45 = fp8lo2(nx.Bs8[nt][ks].y), s67 = fp8hi2(nx.Bs8[nt][ks].y);
            const u32x4 w = (u32x4){cvt_pk_bf16(s01.x, s01.y), cvt_pk_bf16(s23.x, s23.y), cvt_pk_bf16(s45.x, s45.y), cvt_pk_bf16(s67.x, s67.y)};
            Bs[nt][ks] = __builtin_bit_cast(bf16x8, w);
        }
    if (HAS_NEXT) g4_load(nx, zq, ST, u_next, tid, wave, l15, lq);
    __syncthreads();
    for (int tile = wave; tile < 12; tile += 8) {
        if (tile >= 10) {
            const int ti = tile == 10 ? 0 : 2, tj = ti + 1;
#pragma unroll
            for (int r = 0; r < 4; ++r) Pm[(16 * ti + 4 * lq + r) * 72 + 16 * tj + l15] = 0;
        } else {
            const int ti = tile >= 6 ? 3 : (tile >= 3 ? 2 : (tile >= 1 ? 1 : 0)), tj = tile - (ti * (ti + 1)) / 2;
            f32x4 acc = (f32x4){0.f, 0.f, 0.f, 0.f};
#pragma unroll
            for (int ks = 0; ks < 4; ++ks) {
                const bf16x8 a = *(const LAS bf16x8*)(Q + (16 * ti + l15) * 272 + (32 * ks + 8 * lq) * 2);
                const bf16x8 bb = *(const LAS bf16x8*)(Kd + (16 * tj + l15) * 272 + (32 * ks + 8 * lq) * 2);
                acc = mfma16(a, bb, acc);
            }
#pragma unroll
            for (int r = 0; r < 4; ++r) {
                const int i = 16 * ti + 4 * lq + r, j = 16 * tj + l15;
                Pm[i * 72 + j] = (unsigned short)f2bf(j <= i ? acc[r] : 0.f);
            }
        }
    }
    __syncthreads();
    f32x4 acc[4][2];
    {
        bf16x8 Bv[2][2];
#pragma unroll
        for (int nt = 0; nt < 2; ++nt)
#pragma unroll
            for (int ks = 0; ks < 2; ++ks) Bv[nt][ks] = lds_col8(V + (32 * ks + 8 * lq) * 260 + 16 * (2 * wave + nt) + l15, 260, l15);
#pragma unroll
        for (int mt = 0; mt < 4; ++mt) {
            acc[mt][0] = (f32x4){0.f, 0.f, 0.f, 0.f}; acc[mt][1] = (f32x4){0.f, 0.f, 0.f, 0.f};
#pragma unroll
            for (int ks = 0; ks < 2; ++ks) if (ks <= ((16 * mt + 15) >> 5)) {
                const bf16x8 ap = *(const LAS bf16x8*)((const LAS unsigned char*)Pm + (16 * mt + l15) * 144 + (32 * ks + 8 * lq) * 2);
                acc[mt][0] = mfma16(Bv[0][ks], ap, acc[mt][0]); acc[mt][1] = mfma16(Bv[1][ks], ap, acc[mt][1]);
            }
#pragma unroll
            for (int ks = 0; ks < 4; ++ks) {
                const bf16x8 aq = *(const LAS bf16x8*)(Q + (16 * mt + l15) * 272 + (32 * ks + 8 * lq) * 2);
                acc[mt][0] = mfma16(Bs[0][ks], aq, acc[mt][0]); acc[mt][1] = mfma16(Bs[1][ks], aq, acc[mt][1]);
            }
        }
    }
#pragma unroll
    for (int mt = 0; mt < 4; ++mt) {
        float s2 = 0.f;
#pragma unroll
        for (int nt = 0; nt < 2; ++nt) s2 += acc[mt][nt].x * acc[mt][nt].x + acc[mt][nt].y * acc[mt][nt].y + acc[mt][nt].z * acc[mt][nt].z + acc[mt][nt].w * acc[mt][nt].w;
        s2 += __shfl_xor(s2, 16); s2 += __shfl_xor(s2, 32);
        if (lq == 0) part[wave * 64 + 16 * mt + l15] = s2;
    }
    __syncthreads();
#pragma unroll
    for (int mt = 0; mt < 4; ++mt) {
        const int i = 16 * mt + l15; float tot = 0.f;
#pragma unroll
        for (int w8 = 0; w8 < 8; ++w8) tot += part[w8 * 64 + i];
        const float rs = rsqrtf(tot * (1.0f / HV) + EPS);
#pragma unroll
        for (int nt = 0; nt < 2; ++nt) {
            const int vv = 16 * (2 * wave + nt) + 4 * lq;
            const float r0 = bflo(rr[mt][nt].x), r1 = bfhi(rr[mt][nt].x), r2 = bflo(rr[mt][nt].y), r3 = bfhi(rr[mt][nt].y);
            const f32x4 a = acc[mt][nt];
            u32x2 o; o.x = cvt_pk_bf16(a.x * rs * g4[nt].x * siluf_(r0), a.y * rs * g4[nt].y * siluf_(r1)); o.y = cvt_pk_bf16(a.z * rs * g4[nt].z * siluf_(r2), a.w * rs * g4[nt].w * siluf_(r3));
            *(u32x2*)(ob + (size_t)(t0 + i) * 1024 + h * HV + vv) = o;
        }
    }
}
DEVI void phase_g4_fast(const Params& P, int wv, int vc, unsigned char* lds_, int jl) {
    const int tid = opaque_tid(), lane = tid & 63, wave = tid >> 6, l15 = lane & 15, lq = lane >> 4;
    LAS unsigned char* lds = (LAS unsigned char*)lds_;
    const bf16_t* zq = (const bf16_t*)(P.ws + WS_ZBUF);
    bf16_t* ob = (bf16_t*)(P.ws + WS_ZBUF + ZB_OB);
    const unsigned char* ST = P.ws + WS_BUF2;
    const float* gh = P.in[I_GLA_GH] + jl * 1024;
    const int step = (int)(gridDim.x >> 3), ubase = (vc & 7) * 128;
    int ui_ = vc >> 3;
    if (ui_ >= 128) return;
    f32x4 g4[2];
    G4Pre nx;
    g4_load(nx, zq, ST, ubase + ui_, tid, wave, l15, lq);
    for (;;) {
        const int u = ubase + ui_, h = u & 3;
#pragma unroll
        for (int nt = 0; nt < 2; ++nt) g4[nt] = *(const f32x4*)(gh + h * HV + 16 * (2 * wave + nt) + 4 * lq);
        if (ui_ + step < 128) { g4_unit<true>(nx, zq, ob, ST, g4, lds, u, u + step, tid, wave, l15, lq); ui_ += step; }
        else { g4_unit<false>(nx, zq, ob, ST, g4, lds, u, u, tid, wave, l15, lq); break; }
    }
}

struct S2Pre { f32x4 sv[4]; u32x4 vw[4]; unsigned uu[8][2]; };
DEVI void s2_load(S2Pre& p, const unsigned char* z, const float* lnstat, int u, int tid, int wave, int l15, int lq) {
    const int g = u & 7, n = (u >> 3) & 15, b = u >> 7, t0 = b * SEQ + n * SCH;
#pragma unroll
    for (int q = 0; q < 4; ++q) p.sv[q] = *(const f32x4*)(lnstat + (size_t)(t0 + (tid >> 2)) * 64 + 16 * (tid & 3) + 4 * q);
    const int col = g * SGC + (tid & 15) * 16;
#pragma unroll
    for (int i = 0; i < 4; ++i) p.vw[i] = *(const u32x4*)(z + (size_t)(t0 + (tid >> 4) + 32 * i) * SGU_Z + SGU_W + col);
#pragma unroll
    for (int tt = 0; tt < 8; ++tt)
#pragma unroll
        for (int ct = 0; ct < 2; ++ct) p.uu[tt][ct] = *(const unsigned*)(z + (size_t)(t0 + 16 * tt + l15) * SGU_Z + g * SGC + 16 * (2 * wave + ct) + 4 * lq);
}
template <bool HAS_NEXT>
DEVI void s2_unit(S2Pre& nx, const unsigned char* z, bf16_t* ug, const float* lnstat, const float (&gg)[16], const float (&bb)[16], const float (&bias8)[8], LAS unsigned char* lds, int u, int u_next,
                  int tid, int wave, int l15, int lq) {
    LAS unsigned short* X = (LAS unsigned short*)lds;
    LAS unsigned char* Wl = lds + 66560;
    LAS float* mu = (LAS float*)(lds + 101376); LAS float* rsd = mu + 128;
    const int g = u & 7, n = (u >> 3) & 15, b = u >> 7;
    const int t0 = b * SEQ + n * SCH;
    {
        float s1 = 0.f, s2 = 0.f;
#pragma unroll
        for (int q = 0; q < 4; ++q) { s1 += nx.sv[q].x; s2 += nx.sv[q].y; s1 += nx.sv[q].z; s2 += nx.sv[q].w; }
        s1 += __shfl_xor(s1, 1); s2 += __shfl_xor(s2, 1); s1 += __shfl_xor(s1, 2); s2 += __shfl_xor(s2, 2);
        const float mean = s1 * (1.0f / SGU_W); const float var = fmaxf(s2 * (1.0f / SGU_W) - mean * mean, 0.f);
        if ((tid & 3) == 0) { mu[tid >> 2] = mean; rsd[tid >> 2] = rsqrtf(var + EPS); }
    }
    u32x4 vw[4]; unsigned uu[8][2];
#pragma unroll
    for (int i = 0; i < 4; ++i) vw[i] = nx.vw[i];
#pragma unroll
    for (int tt = 0; tt < 8; ++tt) { uu[tt][0] = nx.uu[tt][0]; uu[tt][1] = nx.uu[tt][1]; }
    if (HAS_NEXT) s2_load(nx, z, lnstat, u_next, tid, wave, l15, lq);
    __syncthreads();
    {
        const int cc = tid & 15;
#pragma unroll
        for (int i = 0; i < 4; ++i) {
            const int s = (tid >> 4) + 32 * i;
            const u32x4 w = vw[i];
            const float m = mu[s], r = rsd[s];
            const unsigned wa[4] = {w.x, w.y, w.z, w.w}; unsigned o[8];
#pragma unroll
            for (int j = 0; j < 4; ++j) {
                const f32x2 a = fp8lo2(wa[j]), c = fp8hi2(wa[j]);
                o[2 * j] = cvt_pk_bf16((a.x - m) * r * gg[4 * j] + bb[4 * j], (a.y - m) * r * gg[4 * j + 1] + bb[4 * j + 1]);
                o[2 * j + 1] = cvt_pk_bf16((c.x - m) * r * gg[4 * j + 2] + bb[4 * j + 2], (c.y - m) * r * gg[4 * j + 3] + bb[4 * j + 3]);
            }
#pragma unroll
            for (int j = 0; j < 4; ++j) *(LAS u32x2*)(X + s * 260 + cc * 16 + 4 * j) = (u32x2){o[2 * j], o[2 * j + 1]};
        }
    }
    __syncthreads();
    {
        bf16x8 Bf[2][4];
#pragma unroll
        for (int ct = 0; ct < 2; ++ct)
#pragma unroll
            for (int ks = 0; ks < 4; ++ks) Bf[ct][ks] = lds_col8(X + (32 * ks + 8 * lq) * 260 + 16 * (2 * wave + ct) + l15, 260, l15);
#pragma unroll
        for (int tt = 0; tt < 8; ++tt) {
            f32x4 acc0 = (f32x4){0.f, 0.f, 0.f, 0.f}, acc1 = (f32x4){0.f, 0.f, 0.f, 0.f};
#pragma unroll
            for (int ks = 0; ks < 4; ++ks) if (ks <= ((16 * tt + 15) >> 5)) {
                const bf16x8 af = *(const LAS bf16x8*)(Wl + (16 * tt + l15) * 272 + (32 * ks + 8 * lq) * 2);
                acc0 = mfma16(Bf[0][ks], af, acc0); acc1 = mfma16(Bf[1][ks], af, acc1);
            }
            const int t = 16 * tt + l15; const float bias = bias8[tt];
#pragma unroll
            for (int ct = 0; ct < 2; ++ct) {
                const f32x4 a = ct ? acc1 : acc0; const unsigned uw = uu[tt][ct];
                const f32x2 u01 = gelu_tanh2(fp8lo2(uw)), u23 = gelu_tanh2(fp8hi2(uw));
                u32x2 o; o.x = cvt_pk_bf16(u01.x * (a.x + bias), u01.y * (a.y + bias)); o.y = cvt_pk_bf16(u23.x * (a.z + bias), u23.y * (a.w + bias));
                *(u32x2*)(ug + (size_t)(t0 + t) * SGU_W + g * SGC + 16 * (2 * wave + ct) + 4 * lq) = o;
            }
        }
    }
}
DEVI void phase_s2_fast(const Params& P, int wv, int vc, unsigned char* lds_, int jl) {
    const int tid = opaque_tid(), lane = tid & 63, wave = tid >> 6, l15 = lane & 15, lq = lane >> 4;
    LAS unsigned char* lds = (LAS unsigned char*)lds_;
    LAS unsigned char* Wl = lds + 66560;
    const unsigned char* z = P.ws + WS_ZBUF;
    bf16_t* ug = (bf16_t*)(P.ws + WS_BUF2);
    const float* lnstat = (const float*)(P.ws + WS_LNP) + (size_t)jl * T * 64;
    const bf16_t* wsb = (const bf16_t*)(P.ws + WS_SGUWS) + (size_t)jl * 8 * 128 * 128;
    const float* lng = P.in[I_SGU_LNG] + jl * SGU_W; const float* lnb = P.in[I_SGU_LNB] + jl * SGU_W;
    const float* bs = P.in[I_SGU_BS] + jl * 8 * 128;
    const int step = (int)(gridDim.x >> 3), ubase = (vc & 7) * 128;
    int ui_ = vc >> 3, gcur = -1;
    if (ui_ >= 128) return;
    S2Pre nx;
    s2_load(nx, z, lnstat, ubase + ui_, tid, wave, l15, lq);
    for (;;) {
        const int u = ubase + ui_, g = u & 7;
        __syncthreads();
        if (g != gcur) {
#pragma unroll
            for (int i = 0; i < 4; ++i) { const int q = tid + NTHREADS * i, t = q >> 4, cc = q & 15; *(LAS u32x4*)(Wl + t * 272 + cc * 16) = *(const u32x4*)(wsb + (size_t)g * 16384 + t * 128 + cc * 8); }
            gcur = g;
        }
        float gg[16], bb[16], bias8[8];
        { const int col = g * SGC + (tid & 15) * 16;
#pragma unroll
          for (int e = 0; e < 16; ++e) { gg[e] = lng[col + e]; bb[e] = lnb[col + e]; }
#pragma unroll
          for (int tt = 0; tt < 8; ++tt) bias8[tt] = bs[g * 128 + 16 * tt + l15]; }
        if (ui_ + step < 128) { s2_unit<true>(nx, z, ug, lnstat, gg, bb, bias8, lds, u, u + step, tid, wave, l15, lq); ui_ += step; }
        else { s2_unit<false>(nx, z, ug, lnstat, gg, bb, bias8, lds, u, u, tid, wave, l15, lq); break; }
    }
}

DEVI void phase_router(const Params& P, int wv, int vc, unsigned char* lds, int layer, bool dep) {
    const int tid = opaque_tid(), lane = tid & 63, wave = tid >> 6, l15 = lane & 15, lq = lane >> 4;
    if (dep) {
        if (threadIdx.x == 0) {
            const unsigned* pc = (const unsigned*)(P.ws + CTL_PANEL) + (layer * 64 + ((((vc & 7) * 32 + (vc >> 3)) * 64) >> 8)) * 4;
            unsigned sp = 0; while (__hip_atomic_load(pc, __ATOMIC_RELAXED, __HIP_MEMORY_SCOPE_AGENT) < 4u) { __builtin_amdgcn_s_sleep(1); if (++sp > (1u << 22)) break; }
        }
        __syncthreads();
    }
    LAS unsigned char* Bw = (LAS unsigned char*)lds;
    float* red = (float*)(lds + 132096);
    float* lgt = (float*)(lds + 144384);
    float* ssqt = (float*)(lds + 152576);
    int* r_cls = (int*)(lds + 152832);
    float* r_wlo = (float*)(lds + 152832 + 256);
    float* r_whi = (float*)(lds + 152832 + 512);
    float* r_rs = (float*)(lds + 152832 + 768);
    int* c_base = (int*)(lds + 152832 + 1024);
    const bf16_t* wr = (const bf16_t*)(P.ws + WS_WR) + (size_t)layer * 2 * 32 * D;
    const bf16_t* h = (const bf16_t*)(P.ws + WS_HB1);
    int* cnt = (int*)(P.ws + CTL_CNT) + layer * 32 * CNT_STRIDE;
    int* list = (int*)(P.ws + WS_LIST);
    f32x4* tokinfo = (f32x4*)(P.ws + WS_TOKINFO);
    float brg[4], bre[16];
#pragma unroll
    for (int g = 0; g < 4; ++g) brg[g] = P.in[I_BRG][layer * 4 + g];
#pragma unroll
    for (int e = 0; e < 16; ++e) bre[e] = P.in[I_BRE][layer * 16 + e];
    const int rstep = (int)(gridDim.x >> 3);
    bf16x8 av[16];
    {
        const int bi0 = vc >> 3;
        if (bi0 < 32) {
            const bf16_t* ap = h + (size_t)(((vc & 7) * 32 + bi0) * 64 + 16 * (wave & 3) + l15) * D + (wave >> 2) * 512 + 8 * lq;
#pragma unroll
            for (int ks = 0; ks < 16; ++ks) av[ks] = *(const bf16x8*)(ap + 32 * ks);
        }
    }
    {
        u32x4 wv4[16];
#pragma unroll
        for (int i = 0; i < 16; ++i) wv4[i] = ((const u32x4*)wr)[tid + NTHREADS * i];
#pragma unroll
        for (int i = 0; i < 16; ++i) { const int q = tid + NTHREADS * i; *(LAS u32x4*)(Bw + (q >> 7) * 2064 + (q & 127) * 16) = wv4[i]; }
    }
    __syncthreads();
    for (int bi_ = vc >> 3; bi_ < 32; bi_ += rstep) {
        const int blk = (vc & 7) * 32 + bi_;
        {
            const int mt = wave & 3, kh = wave >> 2;
            const LAS unsigned char* bp = Bw + l15 * 2064 + (kh * 512 + 8 * lq) * 2;
            f32x4 acc0 = (f32x4){0.f, 0.f, 0.f, 0.f}, acc1 = (f32x4){0.f, 0.f, 0.f, 0.f}; float ss = 0.f;
            bf16x8 ac[16];
#pragma unroll
            for (int ks = 0; ks < 16; ++ks) ac[ks] = av[ks];
            if (bi_ + rstep < 32) {
                const bf16_t* ap = h + (size_t)(((vc & 7) * 32 + bi_ + rstep) * 64 + 16 * mt + l15) * D + kh * 512 + 8 * lq;
#pragma unroll
                for (int ks = 0; ks < 16; ++ks) av[ks] = *(const bf16x8*)(ap + 32 * ks);
            }
#pragma unroll
            for (int ks = 0; ks < 16; ++ks) {
                const bf16x8 a = ac[ks];
                const u32x4 aw = __builtin_bit_cast(u32x4, a);
                ss += bflo(aw.x) * bflo(aw.x) + bfhi(aw.x) * bfhi(aw.x) + bflo(aw.y) * bflo(aw.y) + bfhi(aw.y) * bfhi(aw.y) + bflo(aw.z) * bflo(aw.z) + bfhi(aw.z) * bfhi(aw.z) + bflo(aw.w) * bflo(aw.w) + bfhi(aw.w) * bfhi(aw.w);
                acc0 = mfma16(*(const LAS bf16x8*)(bp + 64 * ks), a, acc0);
                acc0 = mfma16(*(const LAS bf16x8*)(bp + 32 * 2064 + 64 * ks), a, acc0);
                acc1 = mfma16(*(const LAS bf16x8*)(bp + 16 * 2064 + 64 * ks), a, acc1);
                acc1 = mfma16(*(const LAS bf16x8*)(bp + 48 * 2064 + 64 * ks), a, acc1);
            }
            ss += __shfl_xor(ss, 16); ss += __shfl_xor(ss, 32);
            __syncthreads();
            if (kh == 1) { float* rp = red + (mt * 64 + lane) * 12; *(f32x4*)rp = acc0; *(f32x4*)(rp + 4) = acc1; rp[8] = ss; }
            __syncthreads();
            if (kh == 0) {
                const float* rp = red + (mt * 64 + lane) * 12;
                acc0 += *(const f32x4*)rp; acc1 += *(const f32x4*)(rp + 4); ss += rp[8];
                float* lp = lgt + (16 * mt + l15) * 32 + 4 * lq;
                *(f32x4*)lp = acc0; *(f32x4*)(lp + 16) = acc1;
                if (lq == 0) ssqt[16 * mt + l15] = ss;
            }
            __syncthreads();
        }
        if (tid < 64) {
            const int rl = tid;
            const float rs = rstd_from_ssq(ssqt[rl]);
            float lg[20];
#pragma unroll
            for (int o = 0; o < 20; ++o) lg[o] = lgt[rl * 32 + o] * rs;
            float gl[4]; int gi = 0;
#pragma unroll
            for (int g = 0; g < 4; ++g) gl[g] = lg[g] + brg[g];
            float gm = gl[0];
#pragma unroll
            for (int g = 1; g < 4; ++g) if (gl[g] > gm) { gm = gl[g]; gi = g; }
            float den = 0.f;
#pragma unroll
            for (int g = 0; g < 4; ++g) den += __expf(gl[g] - gm);
            const float gw = 1.0f / den;
            float el[4];
#pragma unroll
            for (int e = 0; e < 4; ++e) {
                float v = lg[4 + e] + bre[e];
                v = gi == 1 ? lg[8 + e] + bre[4 + e] : v; v = gi == 2 ? lg[12 + e] + bre[8 + e] : v; v = gi == 3 ? lg[16 + e] + bre[12 + e] : v;
                el[e] = v;
            }
            int i1 = 0; float v1 = el[0];
#pragma unroll
            for (int e = 1; e < 4; ++e) if (el[e] > v1) { v1 = el[e]; i1 = e; }
            int i2 = -1; float v2 = -3.0e38f;
#pragma unroll
            for (int e = 0; e < 4; ++e) if (e != i1 && el[e] > v2) { v2 = el[e]; i2 = e; }
            const float ex = __expf(v2 - v1); const float w1 = gw / (1.0f + ex), w2 = gw * ex / (1.0f + ex);
            const int lo = i1 < i2 ? i1 : i2, hi = i1 < i2 ? i2 : i1;
            const float wlo = i1 < i2 ? w1 : w2, whi = i1 < i2 ? w2 : w1;
            const int pair = lo == 0 ? hi - 1 : (lo == 1 ? hi + 1 : 5);
            r_cls[rl] = gi * 6 + pair; r_wlo[rl] = wlo; r_whi[rl] = whi; r_rs[rl] = rs;
        }
        __syncthreads();
        int cb = 0, myc = 0, rank = 0;
        if (tid < NCLS) { int c = 0; for (int r = 0; r < 64; ++r) c += (r_cls[r] == tid) ? 1 : 0; if (c) cb = atomicAdd(cnt + tid * CNT_STRIDE, c); }
        if (tid < 64) { myc = r_cls[tid]; for (int r = 0; r < tid; ++r) rank += (r_cls[r] == myc) ? 1 : 0; }
        if (tid < NCLS) c_base[tid] = cb;
        __syncthreads();
        if (tid < 64) {
            const int row = blk * 64 + tid;
            list[(size_t)myc * T + c_base[myc] + rank] = row;
            tokinfo[row] = (f32x4){r_rs[tid], r_wlo[tid], r_whi[tid], 0.f};
        }
        __syncthreads();
    }
}

DEVI void phase_final(const Params& P, int wv, int vc) {
    const int tid = opaque_tid(), lane = tid & 63, wave = tid >> 6;
    const int lw = (vc >> 3) * NWAVES + wave, nlw = (int)(gridDim.x >> 3) * NWAVES, rbase = (vc & 7) * SEQ;
    const bf16_t* h = (const bf16_t*)(P.ws + WS_HB0); const float* g = P.in[I_FINAL];
    f32x4 gg[4];
#pragma unroll
    for (int q = 0; q < 4; ++q) gg[q] = *(const f32x4*)(g + (q >> 1) * 512 + 8 * lane + 4 * (q & 1));
    for (int r0 = lw; r0 < SEQ; r0 += 8 * nlw) {
        u32x4 w[8][2];
#pragma unroll
        for (int r = 0; r < 8; ++r) { const int rr = r0 + r * nlw; const u32x4* hr = (const u32x4*)(h + (size_t)(rbase + (rr < SEQ ? rr : 0)) * D) + lane; w[r][0] = hr[0]; w[r][1] = hr[64]; }
#pragma unroll
        for (int r = 0; r < 8; ++r) {
            const int rr = r0 + r * nlw; if (rr < SEQ) {
            const int row = rbase + rr;
            const u32x4 w0 = w[r][0], w1 = w[r][1];
            float v[16] = {bflo(w0.x), bfhi(w0.x), bflo(w0.y), bfhi(w0.y), bflo(w0.z), bfhi(w0.z), bflo(w0.w), bfhi(w0.w), bflo(w1.x), bfhi(w1.x), bflo(w1.y), bfhi(w1.y), bflo(w1.z), bfhi(w1.z), bflo(w1.w), bfhi(w1.w)};
            float ss = 0.f;
#pragma unroll
            for (int j = 0; j < 16; ++j) ss += v[j] * v[j];
            ss = wave_sum(ss);
            const float rs = rstd_from_ssq(ss);
#pragma unroll
            for (int q = 0; q < 4; ++q) {
                const int col = (q >> 1) * 512 + 8 * lane + 4 * (q & 1);
                *(f32x4*)(P.out + (size_t)row * D + col) = (f32x4){v[4 * q] * rs * gg[q].x, v[4 * q + 1] * rs * gg[q].y, v[4 * q + 2] * rs * gg[q].z, v[4 * q + 3] * rs * gg[q].w};
            }
            }
        }
    }
}

DEVI float* ssq_ptr(const Params& P, int wv, int vc, int layer, int which) { return (float*)(P.ws + WS_SSQP) + (size_t)(layer * 2 + which) * T * 16; }

DEVI void phase_g1_gemm(const Params& P, int wv, int vc, unsigned char* lds, int jl, int layer) {
    PlainSched S; S.init((const bf16_t*)(P.ws + WS_HB0), D, (const bf16_t*)(P.ws + WS_GLA_IN) + (size_t)jl * GLA_IN * D, D, T, GLA_Z, gridDim.x, vc);
    const RstdHook<PlainSched> hook{wv, lds, &S, ssq_ptr(P, wv, vc, layer, 0)};
    EpiZ E{(bf16_t*)(P.ws + WS_ZBUF), GLA_Z, (const LAS float*)((LAS unsigned char*)lds + LDS_RTAB), 0, nullptr, 0};
    gemm_run<false>(wv, lds, GemmShape{D, D, D, D, false}, S, E, hook);
}
DEVI void phase_s1_gemm(const Params& P, int wv, int vc, unsigned char* lds, int jl, int layer) {
    PlainSched S; S.init((const bf16_t*)(P.ws + WS_HB0), D, (const bf16_t*)(P.ws + WS_SGU_IN) + (size_t)jl * SGU_Z * D, D, T, SGU_Z, gridDim.x, vc);
    const RstdHook<PlainSched> hook{wv, lds, &S, ssq_ptr(P, wv, vc, layer, 0)};
    EpiZT<true> E{(bf16_t*)(P.ws + WS_ZBUF), SGU_Z, (const LAS float*)((LAS unsigned char*)lds + LDS_RTAB), 1, (float*)(P.ws + WS_LNP) + (size_t)jl * T * 64, 8};
    gemm_run<false>(wv, lds, GemmShape{D, D, D, D, false}, S, E, hook);
}
DEVI void phase_mixout_gemm(const Params& P, int wv, int vc, unsigned char* lds, int jl, int layer, bool gla, bool sig) {
    EpiRes<false> E{(const bf16_t*)(P.ws + WS_HB0), (bf16_t*)(P.ws + WS_HB1), nullptr, nullptr, nullptr};
    PlainSched S;
    if (gla) { S.init((const bf16_t*)(P.ws + WS_ZBUF + ZB_OB), D, (const bf16_t*)(P.ws + WS_GLA_OUT) + (size_t)jl * D * D, D, T, D, gridDim.x, vc); gemm_run<false>(wv, lds, GemmShape{D, D, D, D, false}, S, E); }
    else { S.init((const bf16_t*)(P.ws + WS_BUF2), SGU_W, (const bf16_t*)(P.ws + WS_SGU_OUT) + (size_t)jl * D * SGU_W, SGU_W, T, D, gridDim.x, vc); gemm_run<false>(wv, lds, GemmShape{SGU_W, SGU_W, SGU_W, SGU_W, false}, S, E); }
    if (sig && threadIdx.x == 0) { Unit u; for (int i = 0; S.next(i, u); ++i) (void)__hip_atomic_fetch_add((unsigned*)(P.ws + CTL_PANEL) + (layer * 64 + u.pm) * 4, 1u, __ATOMIC_RELAXED, __HIP_MEMORY_SCOPE_AGENT); }
}
struct FillSched {
    const bf16_t* A; const bf16_t* Bt; int lda, ldb, j, stride, ntot;
    DEVI bool next(int i, Unit& u) const {
        if (j < 0) return false;
        const int un = j + i * stride; if (un >= ntot) return false;
        u.pm = un >> 2; u.pn = un & 3; u.A = A + (size_t)u.pm * 256 * lda; u.rows = nullptr; u.nvalid = 256; u.B0 = Bt + (size_t)u.pn * 256 * ldb; u.B1 = u.B0; u.aux0 = 0; u.aux1 = 0; u.idx = i;
        return true;
    }
};
DEVI void phase_pleup_gemm(const Params& P, int wv, int vc, unsigned char* lds, int layer, int n_gemm_units, bool grp) {
    int G = gridDim.x, c = vc;
    int j, stride;
    if (grp) {
        const int ntile_all = __builtin_amdgcn_readfirstlane(((const LAS int*)((LAS unsigned char*)lds + LDS_SCHED))[NCLS]);
        const int G32 = G >> 3, x = vc & 7, rank = vc >> 3, q = ntile_all >> 3, rem = ntile_all & 7;
        int idle_before = 0, idle_total = 0, my_c0 = G32;
#pragma unroll 1
        for (int xx = 0; xx < 8; ++xx) {
            const int nt = q + (xx < rem ? 1 : 0), n2 = 8 * nt, n3 = 4 * nt;
            const int nA = n2 < 2 * G32 ? n2 : 2 * G32, nB = n2 - nA, wB = nB < G32 ? nB : G32, dB = (G32 - wB) < n3 ? (G32 - wB) : n3, nC = n3 - dB;
            const int idle = nC < G32 ? G32 - nC : 0;
            if (xx < x) idle_before += idle;
            if (xx == x) my_c0 = nC < G32 ? nC : G32;
            idle_total += idle;
        }
        if (3 * idle_total >= 256) { j = rank >= my_c0 ? idle_before + rank - my_c0 : -1; stride = idle_total; }
        else { j = vc; stride = G; }
        (void)n_gemm_units; (void)c;
    } else {
        int c0 = __builtin_amdgcn_readfirstlane(n_gemm_units); while (c0 > G) c0 -= G;
        if (3 * (G - c0) >= G) { j = c >= c0 ? c - c0 : -1; stride = G - c0; }
        else { j = c; stride = G; }
    }
    FillSched S{(const bf16_t*)(P.ws + WS_PB), (const bf16_t*)(P.ws + WS_PLE_UP) + (size_t)layer * D * PLE, PLE, PLE, j, stride, 256};
    EpiZ E{(bf16_t*)(P.ws + WS_UPLE), D, nullptr, 0, nullptr, 0};
    gemm_run<false>(wv, lds, GemmShape{PLE, PLE, PLE, PLE, false}, S, E);
}
DEVI void phase_moe_up(const Params& P, int wv, int vc, unsigned char* lds, int layer, int mode, bool grp) {
    LAS int* pre = (LAS int*)((LAS unsigned char*)lds + LDS_SCHED); LAS int* cn = pre + 32; LAS int* rl = pre + 64;
    (void)moe_sched_setup(P, wv, vc, layer, pre, cn, rl, 8, mode, grp);
    MoeSched S{pre, cn, rl, 8, (int)gridDim.x, vc, true, (const bf16_t*)(P.ws + WS_HB1), (const bf16_t*)(P.ws + WS_MOE_UP)};
    EpiAct E{(bf16_t*)(P.ws + WS_ZBUF), (const f32x4*)(P.ws + WS_TOKINFO)};
    gemm_run<true>(wv, lds, GemmShape{D, D, D, D, true}, S, E, NoHook{}, MoeListHook{wv, pre, cn, rl, (const int*)(P.ws + WS_LIST), true});
}
DEVI int phase_moe_down(const Params& P, int wv, int vc, unsigned char* lds, int layer, int mode, bool grp) {
    LAS int* pre = (LAS int*)((LAS unsigned char*)lds + LDS_SCHED); LAS int* cn = pre + 32; LAS int* rl = pre + 64;
    const int N = moe_sched_setup(P, wv, vc, layer, pre, cn, rl, 4, mode, grp);
    MoeSched S{pre, cn, rl, 4, (int)gridDim.x, vc, false, (const bf16_t*)(P.ws + WS_ZBUF), (const bf16_t*)(P.ws + WS_MOE_DN)};
    EpiRes<false> E{(const bf16_t*)(P.ws + WS_HB1), (bf16_t*)(P.ws + WS_HB1), ssq_ptr(P, wv, vc, layer, 1), nullptr, nullptr};
    gemm_run<false>(wv, lds, GemmShape{1024, 512, 1024, 512, false}, S, E, MoeListHook{wv, pre, cn, rl, (const int*)(P.ws + WS_LIST), false});
    return N;
}
DEVI void phase_ple_gemm(const Params& P, int wv, int vc, unsigned char* lds, int layer) {
    PlainSched S; S.init((const bf16_t*)(P.ws + WS_HB1), D, (const bf16_t*)(P.ws + WS_PLE_GATE) + (size_t)layer * D * D, D, T, D, gridDim.x, vc);
    const RstdHook<PlainSched> hook{wv, lds, &S, ssq_ptr(P, wv, vc, layer, 1)};
    EpiRes<true> E{(const bf16_t*)(P.ws + WS_HB1), (bf16_t*)(P.ws + WS_HB0), layer < NLAYER - 1 ? ssq_ptr(P, wv, vc, layer + 1, 0) : nullptr, (const bf16_t*)(P.ws + WS_UPLE), (const LAS float*)((LAS unsigned char*)lds + LDS_RTAB)};
    gemm_run<false>(wv, lds, GemmShape{D, D, D, D, false}, S, E, hook);
}

#define XB_TMO      128
#define XB_XCNT(j)  (256  + 64 * (j))
#define XB_XSUB(j)  (1280 + 64 * (j))
#define XB_XGEN(j)  (2304 + 64 * (j))
#define XB_TOP      3328
#define XB_TOPGEN   3392
#define XCD_BAR_WORDS 3456
#define XB_SPIN_CAP (1u << 18)
__device__ __forceinline__ unsigned xb_ld(unsigned* p)              { return __hip_atomic_load(p, __ATOMIC_RELAXED, __HIP_MEMORY_SCOPE_AGENT); }
__device__ __forceinline__ unsigned xb_add(unsigned* p, unsigned v) { return __hip_atomic_fetch_add(p, v, __ATOMIC_RELAXED, __HIP_MEMORY_SCOPE_AGENT); }
__device__ __forceinline__ unsigned xb_xcc_id() { return (unsigned)__builtin_amdgcn_s_getreg((3 << 11) | 20) & 0xFu; }
#define XB_SPIN(cond, bar) do { unsigned _sp = 0; while (cond) { __builtin_amdgcn_s_sleep(1); \
    if ((++_sp & 255u) == 0u) { if (xb_ld(&(bar)[XB_TMO])) break; if (_sp > XB_SPIN_CAP) { atomicAdd(&(bar)[XB_TMO], 1u); break; } } } } while (0)
struct XcdBarrier {
    unsigned* bar; unsigned x;
    volatile LAS unsigned* st;
};
__device__ __forceinline__ XcdBarrier xcd_barrier_post(unsigned* bar, volatile LAS unsigned* st) {
    XcdBarrier b; b.bar = bar; b.x = (unsigned)__builtin_amdgcn_readfirstlane((int)xb_xcc_id()); b.st = st;
    if (threadIdx.x == 0) (void)xb_add(&bar[XB_XCNT(b.x)], 1u);
    return b;
}
__device__ __forceinline__ void xcd_barrier_complete(unsigned* bar, unsigned x, unsigned& nloc, unsigned& nx) {
    const unsigned G = gridDim.x * gridDim.y * gridDim.z;
    unsigned sum, cnt, mine, sp = 0u;
    for (;;) {
        sum = 0u; cnt = 0u; mine = 0u;
#pragma unroll
        for (unsigned j = 0; j < 16; ++j) { const unsigned c = xb_ld(&bar[XB_XCNT(j)]); sum += c; cnt += (c > 0u) ? 1u : 0u; mine = (j == x) ? c : mine; }
        if (sum == G) break;
        __builtin_amdgcn_s_sleep(1);
        if ((++sp & 255u) == 0u) { if (xb_ld(&bar[XB_TMO])) break; if (sp > XB_SPIN_CAP) { atomicAdd(&bar[XB_TMO], 1u); break; } }
    }
    nloc = mine > 0u ? mine : 1u; nx = cnt > 0u ? cnt : 1u;
}
__device__ __forceinline__ void xcd_barrier(const XcdBarrier& b) {
    asm volatile("s_waitcnt vmcnt(0)" ::: "memory");
    __syncthreads();
    if (threadIdx.x == 0) {
        unsigned* bar = b.bar; unsigned bx = b.x;
        asm volatile("" : "+s"(bar), "+s"(bx));
        __builtin_amdgcn_s_waitcnt(0);
        unsigned nloc = b.st[0], nx = b.st[1];
        if (nloc == 0u) { xcd_barrier_complete(bar, bx, nloc, nx); b.st[0] = nloc; b.st[1] = nx; }
        const unsigned old = xb_add(&bar[XB_XSUB(bx)], 1u);
        const unsigned gen = old / nloc;
        if (old + 1u == (gen + 1u) * nloc) {
            __builtin_amdgcn_fence(__ATOMIC_RELEASE, "agent");
            asm volatile("s_waitcnt vmcnt(0)" ::: "memory");
            const unsigned og = xb_add(&bar[XB_TOP], 1u);
            const unsigned tg = og / nx;
            if (og + 1u == (tg + 1u) * nx) xb_add(&bar[XB_TOPGEN], 1u);
            else XB_SPIN(xb_ld(&bar[XB_TOPGEN]) == tg, bar);
            __builtin_amdgcn_fence(__ATOMIC_ACQUIRE, "agent");
            xb_add(&bar[XB_XGEN(bx)], 1u);
            asm volatile("s_waitcnt vmcnt(0)" ::: "memory");
        } else {
            XB_SPIN(xb_ld(&bar[XB_XGEN(bx)]) == gen, bar);
            __builtin_amdgcn_fence(__ATOMIC_ACQUIRE, "agent");
            asm volatile("s_waitcnt vmcnt(0)" ::: "memory");
        }
    }
    __syncthreads();
}

constexpr size_t CTL_ROLE = 98304;
constexpr size_t CTL_LB = 106496;
__device__ __forceinline__ void xcd_local_barrier(unsigned* cw, unsigned target, unsigned* tmo_bar) {
    asm volatile("s_waitcnt vmcnt(0)" ::: "memory");
    __syncthreads();
    if (threadIdx.x == 0) {
        asm volatile("" : "+s"(cw));
        (void)xb_add(cw, 1u);
        asm volatile("buffer_inv sc1" ::: "memory");
        XB_SPIN(xb_ld(cw) < target, tmo_bar);
        asm volatile("s_waitcnt vmcnt(0)" ::: "memory");
    }
    __syncthreads();
}

#ifndef FORCE_GLOBAL_BARRIERS
#define FORCE_GLOBAL_BARRIERS 0
#endif
__global__ void __launch_bounds__(NTHREADS, 2) mega(Params P) {
    extern __shared__ __attribute__((aligned(16))) unsigned char lds[];
    const int wv = __builtin_amdgcn_readfirstlane((int)(threadIdx.x >> 6));
    volatile LAS unsigned* xbw = (volatile LAS unsigned*)((LAS unsigned char*)lds + LDS_XB);
    if (threadIdx.x < 4) xbw[threadIdx.x] = 0u;
    __syncthreads();
    const unsigned myx = (unsigned)__builtin_amdgcn_readfirstlane((int)xb_xcc_id());
    if (threadIdx.x == 0) xbw[2] = xb_add((unsigned*)(P.ws + CTL_ROLE) + 64 * myx, 1u);
    const XcdBarrier bar = xcd_barrier_post((unsigned*)(P.ws + CTL_BAR), xbw);
    int vc = blockIdx.x;
    phase_prologue(P, wv, vc, lds);
    xcd_barrier(bar);
    bool uniform = false;
    {
        const unsigned G8 = gridDim.x >> 3; unsigned okc = 0;
#pragma unroll
        for (unsigned j = 0; j < 8; ++j) okc += (xb_ld((unsigned*)(P.ws + CTL_ROLE) + 64 * j) == G8) ? 1u : 0u;
        uniform = !FORCE_GLOBAL_BARRIERS && (gridDim.x & 7u) == 0u && okc == 8u && myx < 8u;
        uniform = __builtin_amdgcn_readfirstlane((int)uniform) != 0;
        if (uniform) vc = (int)(xbw[2] * 8u + myx);
        vc = __builtin_amdgcn_readfirstlane(vc);
    }
    unsigned* lbw = (unsigned*)(P.ws + CTL_LB) + 64 * myx;
    const unsigned nloc = gridDim.x >> 3; unsigned lb_target = 0u;
#define LBAR() do { if (uniform) { lb_target += nloc; xcd_local_barrier(lbw, lb_target, (unsigned*)(P.ws + CTL_BAR)); } else xcd_barrier(bar); } while (0)
#pragma unroll 1
    for (int layer = 0; layer < NLAYER; ++layer) {
        const int jl = layer >> 1;
        const bool pre_first = ((vc & 1) == 0) || !uniform;
        if (pre_first) phase_layer_pre(P, wv, vc, lds, layer, uniform);
        if ((layer & 1) == 0) {
            phase_g1_gemm(P, wv, vc, lds, jl, layer); phase_aproj(P, wv, vc, lds, jl, layer);
            LBAR();
            phase_g2_fast(P, wv, vc, lds, jl);
            LBAR();
            phase_g3(P, wv, vc, lds);
            LBAR();
            phase_g4_fast(P, wv, vc, lds, jl);
            LBAR();
            phase_mixout_gemm(P, wv, vc, lds, jl, layer, true, uniform && gridDim.x == 256);
        } else {
            phase_s1_gemm(P, wv, vc, lds, jl, layer);
            LBAR();
            phase_s2_fast(P, wv, vc, lds, jl);
            LBAR();
            phase_mixout_gemm(P, wv, vc, lds, jl, layer, false, uniform && gridDim.x == 256);
        }
        if (!pre_first) phase_layer_pre(P, wv, vc, lds, layer, uniform);
        const bool pdep = uniform && gridDim.x == 256;
        if (!pdep) LBAR();
        phase_router(P, wv, vc, lds, layer, pdep);
        xcd_barrier(bar);
        phase_moe_up(P, wv, vc, lds, layer, MOE_UP_A, uniform);
        LBAR();
        phase_moe_up(P, wv, vc, lds, layer, MOE_UP_B, uniform);
        (void)phase_moe_down(P, wv, vc, lds, layer, MOE_DN_B, uniform);
        LBAR();
        {
            const int nC = phase_moe_down(P, wv, vc, lds, layer, MOE_DN_C, uniform);
            phase_pleup_gemm(P, wv, vc, lds, layer, nC, uniform);
        }
        xcd_barrier(bar);
        phase_ple_gemm(P, wv, vc, lds, layer);
        LBAR();
    }
    phase_final(P, wv, vc);
}

extern "C" void kernel_launch(void* const* d_in, const int* in_sizes, int n_in, void* d_out, int out_size, void* d_ws, size_t ws_size, hipStream_t stream) {
    static int grid = 0;
    if (grid == 0) {
        if (n_in != 26 || ws_size < WS_END) { fprintf(stderr, "kernel_launch: unexpected n_in %d or ws_size %zu\n", n_in, ws_size); grid = -1; return; }
        int dev = 0, cus = 0;
        if (hipGetDevice(&dev) != hipSuccess || hipDeviceGetAttribute(&cus, hipDeviceAttributeMultiprocessorCount, dev) != hipSuccess) { grid = -1; return; }
        if (hipFuncSetAttribute((const void*)mega, hipFuncAttributeMaxDynamicSharedMemorySize, LDS_BYTES) != hipSuccess) { fprintf(stderr, "kernel_launch: hipFuncSetAttribute failed\n"); grid = -1; return; }
        grid = cus < 256 ? cus : 256;
    }
    if (grid < 0) return;
    Params P{};
    for (int i = 0; i < 26; ++i) P.in[i] = (const float*)d_in[i];
    P.out = (float*)d_out; P.ws = (unsigned char*)d_ws;
    (void)hipMemsetAsync((char*)d_ws + CTL_BAR, 0, CTL_CNT + 4 * 32 * CNT_STRIDE * sizeof(int) - CTL_BAR, stream);
    hipLaunchKernelGGL(mega, dim3(grid), dim3(NTHREADS), LDS_BYTES, stream, P);
}
```
